# Optimizing an MI355X kernel written in HIP

```python
import math
import jax, jax.numpy as jnp
from jax import lax
import numpy as np

D_MODEL = 2048
BATCH = 8
SEQ = 4096
DEPTH = 1

N_META = 16
BLOCK_Q = 128
SB_HEADS = 8
SB_HEAD_DIM = 128
SB_WIDTH = SB_HEADS * SB_HEAD_DIM
DIFF_HEADS = 8
DIFF_QK_DIM = 64
DIFF_V_DIM = 2 * DIFF_QK_DIM
DIFF_QK_WIDTH = DIFF_HEADS * 2 * DIFF_QK_DIM
DIFF_WIDTH = DIFF_HEADS * DIFF_V_DIM
MIX_WIDTH = SB_WIDTH + DIFF_WIDTH
IN_SIZES = (SB_WIDTH, SB_WIDTH, SB_WIDTH, SB_WIDTH,
            DIFF_QK_WIDTH, DIFF_QK_WIDTH, DIFF_WIDTH, DIFF_WIDTH)
IN_WIDTH = 4 * SB_WIDTH + 2 * DIFF_QK_WIDTH + 2 * DIFF_WIDTH
ROPE_THETA = 500000.0
ROT_DIM = DIFF_QK_DIM // 4
RMS_EPS = 1e-6
SUBLN_EPS = 1e-5

kernel_name = "hybrid_stickbreak_diffattn_layer"


def rms_norm(x, w, eps=RMS_EPS):
    xf = x.astype(jnp.float32)
    y = xf * lax.rsqrt(jnp.mean(xf * xf, axis=-1, keepdims=True) + eps)
    return (y * w.astype(jnp.float32)).astype(x.dtype)


def lambda_init_for(layer):
    return 0.8 - 0.6 * math.exp(-0.3 * layer)


def partial_rope(x, cos, sin):
    half = ROT_DIM // 2
    c = cos[None, :, None, None, :]
    s = sin[None, :, None, None, :]
    x1 = x[..., :half]
    x2 = x[..., half:ROT_DIM]
    return jnp.concatenate([x1 * c - x2 * s, x2 * c + x1 * s, x[..., ROT_DIM:]], axis=-1)


def stick_breaking_block(q, k, v, q_pos, k_pos):
    z = jnp.einsum('bhqd,bhkd->bhqk', q, k) / math.sqrt(q.shape[-1])
    mask = k_pos[None, :] < q_pos[:, None]
    log_beta = jax.nn.log_sigmoid(z)
    log_keep = jnp.where(mask, jax.nn.log_sigmoid(-z), 0.0)
    tail = lax.cumsum(log_keep, axis=3, reverse=True) - log_keep
    a = jnp.where(mask, jnp.exp(log_beta + tail), 0.0)
    return jnp.einsum('bhqk,bhkd->bhqd', a, v)


def diff_attention_block(q, k, v, lam, q_pos, k_pos):
    s = jnp.einsum('bhcqd,bhckd->bhcqk', q, k) / math.sqrt(q.shape[-1])
    mask = k_pos[None, :] <= q_pos[:, None]
    p = jax.nn.softmax(jnp.where(mask, s, -jnp.inf), axis=-1)
    w = p[:, :, 0] - lam * p[:, :, 1]
    return jnp.einsum('bhqk,bhkd->bhqd', w, v)


def setup_inputs(seed: int = 0) -> dict:
    key = jax.random.key(seed)
    ks = jax.random.split(key, 13)
    f32 = jnp.float32
    x = jax.random.normal(ks[0], (BATCH, SEQ, D_MODEL), f32)
    meta = jax.random.normal(ks[1], (N_META, D_MODEL), f32)
    norm_w = 1.0 + 0.02 * jax.random.normal(ks[2], (DEPTH, D_MODEL), f32)
    w_in = jax.random.normal(ks[3], (DEPTH, D_MODEL, IN_WIDTH), f32) * D_MODEL ** -0.5
    q_norm_w = 1.0 + 0.02 * jax.random.normal(ks[4], (DEPTH, DIFF_QK_DIM), f32)
    k_norm_w = 1.0 + 0.02 * jax.random.normal(ks[5], (DEPTH, DIFF_QK_DIM), f32)
    lambda_q1 = 0.1 * jax.random.normal(ks[6], (DEPTH, DIFF_QK_DIM), f32)
    lambda_k1 = 0.1 * jax.random.normal(ks[7], (DEPTH, DIFF_QK_DIM), f32)
    lambda_q2 = 0.1 * jax.random.normal(ks[8], (DEPTH, DIFF_QK_DIM), f32)
    lambda_k2 = 0.1 * jax.random.normal(ks[9], (DEPTH, DIFF_QK_DIM), f32)
    subln_w = 1.0 + 0.02 * jax.random.normal(ks[10], (DEPTH, DIFF_V_DIM), f32)
    w_out = jax.random.normal(ks[11], (DEPTH, MIX_WIDTH, D_MODEL), f32) * MIX_WIDTH ** -0.5
    return {"x": x, "meta": meta, "norm_w": norm_w, "w_in": w_in,
            "q_norm_w": q_norm_w, "k_norm_w": k_norm_w,
            "lambda_q1": lambda_q1, "lambda_k1": lambda_k1,
            "lambda_q2": lambda_q2, "lambda_k2": lambda_k2,
            "subln_w": subln_w, "w_out": w_out}


def reference(x, meta, norm_w, w_in, q_norm_w, k_norm_w, lambda_q1, lambda_k1,
              lambda_q2, lambda_k2, subln_w, w_out):
    f32 = jnp.float32
    b, seq = x.shape[0], x.shape[1]
    h = jnp.concatenate(
        [jnp.broadcast_to(meta[None].astype(x.dtype), (b, N_META, D_MODEL)), x], axis=1)
    t_all = h.shape[1]
    pos = jnp.arange(t_all, dtype=f32)
    inv_freq = ROPE_THETA ** (-jnp.arange(0, ROT_DIM, 2, dtype=f32) / ROT_DIM)
    ang = pos[:, None] * inv_freq[None, :]
    cos, sin = jnp.cos(ang), jnp.sin(ang)
    split_at = list(np.cumsum(IN_SIZES)[:-1])
    real_blocks = [(N_META + i * BLOCK_Q, N_META + (i + 1) * BLOCK_Q)
                   for i in range(seq // BLOCK_Q)]

    for l in range(DEPTH):
        last = l == DEPTH - 1
        q_start = N_META if last else 0
        blocks = ([] if last else [(0, N_META)]) + real_blocks
        lam_init = lambda_init_for(l)

        u = rms_norm(h, norm_w[l])
        proj = jnp.einsum('btd,de->bte', u, w_in[l])
        sb_q, sb_k, sb_v, sb_g, df_q, df_k, df_v, df_g = jnp.split(proj, split_at, axis=-1)

        def heads(t, n, d):
            return t.reshape(b, t.shape[1], n, d).transpose(0, 2, 1, 3).astype(f32)

        sbq = heads(sb_q[:, q_start:], SB_HEADS, SB_HEAD_DIM)
        sbk = heads(sb_k, SB_HEADS, SB_HEAD_DIM)
        sbv = heads(sb_v, SB_HEADS, SB_HEAD_DIM)

        dq = df_q.reshape(b, t_all, DIFF_HEADS, 2, DIFF_QK_DIM).astype(f32)
        dk = df_k.reshape(b, t_all, DIFF_HEADS, 2, DIFF_QK_DIM).astype(f32)
        dq = partial_rope(rms_norm(dq, q_norm_w[l]), cos, sin).transpose(0, 2, 3, 1, 4)
        dk = partial_rope(rms_norm(dk, k_norm_w[l]), cos, sin).transpose(0, 2, 3, 1, 4)
        dq = dq[:, :, :, q_start:]
        dv = heads(df_v, DIFF_HEADS, DIFF_V_DIM)
        lam = (jnp.exp(jnp.sum(lambda_q1[l].astype(f32) * lambda_k1[l].astype(f32)))
               - jnp.exp(jnp.sum(lambda_q2[l].astype(f32) * lambda_k2[l].astype(f32)))
               + lam_init)

        sb_outs, df_outs = [], []
        for (a, e) in blocks:
            q_pos = jnp.arange(a, e)
            k_pos = jnp.arange(e)
            qa, qe = a - q_start, e - q_start
            sb_outs.append(stick_breaking_block(
                sbq[:, :, qa:qe], sbk[:, :, :e], sbv[:, :, :e], q_pos, k_pos))
            df_outs.append(diff_attention_block(
                dq[:, :, :, qa:qe], dk[:, :, :, :e], dv[:, :, :e], lam, q_pos, k_pos))

        t_q = t_all - q_start
        sb_o = jnp.concatenate(sb_outs, axis=2).transpose(0, 2, 1, 3).reshape(b, t_q, SB_WIDTH)
        df_o = jnp.concatenate(df_outs, axis=2).transpose(0, 2, 1, 3)
        df_o = (rms_norm(df_o, subln_w[l], SUBLN_EPS) * (1.0 - lam_init)).reshape(b, t_q, DIFF_WIDTH)

        mixed = jnp.concatenate(
            [sb_o * jax.nn.silu(sb_g[:, q_start:].astype(f32)),
             df_o * jax.nn.silu(df_g[:, q_start:].astype(f32))], axis=-1).astype(h.dtype)
        y = jnp.einsum('bte,ed->btd', mixed, w_out[l])
        h = jnp.concatenate([h[:, :q_start], h[:, q_start:] + y], axis=1)

    return h[:, N_META:]
```

```cpp
#include <hip/hip_runtime.h>
#include <hip/hip_cooperative_groups.h>
#include <cstdio>
#include <cstdint>
namespace cg = cooperative_groups;

#define LAS __attribute__((address_space(3)))
#define DI __device__ __forceinline__
typedef unsigned short bf16_t;
typedef short bf16x8 __attribute__((ext_vector_type(8)));
typedef short s16x4 __attribute__((ext_vector_type(4)));
typedef float f32x4 __attribute__((ext_vector_type(4)));
typedef float f32x16 __attribute__((ext_vector_type(16)));
typedef unsigned u32x4 __attribute__((ext_vector_type(4)));
typedef unsigned u32x2 __attribute__((ext_vector_type(2)));

constexpr int BATCH = 8, SEQ = 4096, DM = 2048, NMETA = 16, INW = 8192;
constexpr int MROWS = BATCH * SEQ;
constexpr int TPAD = SEQ + 64;
constexpr int NH = 8, HD = 128, NBH = BATCH * NH;
constexpr float RMS_EPS = 1e-6f, SUBLN_EPS = 1e-5f, LAM_INIT = 0.2f;
constexpr float LOG2E = 1.4426950408889634f;
constexpr bool SB_EARLY_EXIT = true;
#ifndef PROBE_PHASE
#define PROBE_PHASE (-1)
#endif
#ifndef PROBE_VAR
#define PROBE_VAR 1
#endif
#ifndef PROBE_REPS
#define PROBE_REPS 2
#endif
#define REPS(k) ((PROBE_PHASE == (k)) ? PROBE_REPS : 1)

constexpr size_t MiB = 1u << 20;
constexpr size_t WS_CTL = 0, WS_ROPE = 1 * MiB, WS_MPART = 2 * MiB, WS_WIN = 16 * MiB, WS_WOUT = 48 * MiB, WS_XN = 64 * MiB,
                 WS_G = 192 * MiB, WS_MIX = 320 * MiB, WS_SBQ = 448 * MiB, WS_SBK = 512 * MiB, WS_SBV = 578 * MiB,
                 WS_DFQ = 644 * MiB, WS_DFK = 708 * MiB, WS_DFV = 774 * MiB, WS_END = 840 * MiB;
constexpr int CW_LAM = 0, CW_BOFF = 1, CW_QUEUE = 64;

constexpr int LDS_BYTES = 147456;

DI unsigned cvt_pk_bf16(float lo, float hi) { unsigned r; asm volatile("v_cvt_pk_bf16_f32 %0, %1, %2" : "=v"(r) : "v"(lo), "v"(hi)); return r; }
DI float bf_lo(unsigned w) { return __uint_as_float(w << 16); }
DI float bf_hi(unsigned w) { return __uint_as_float(w & 0xffff0000u); }
DI float wave_sum(float v) {
    v += __int_as_float(__builtin_amdgcn_update_dpp(0, __float_as_int(v), 0xB1, 0xF, 0xF, true));
    v += __int_as_float(__builtin_amdgcn_update_dpp(0, __float_as_int(v), 0x4E, 0xF, 0xF, true));
    v += __int_as_float(__builtin_amdgcn_update_dpp(0, __float_as_int(v), 0x141, 0xF, 0xF, true));
    v += __int_as_float(__builtin_amdgcn_update_dpp(0, __float_as_int(v), 0x140, 0xF, 0xF, true));
    v += __shfl_xor(v, 16);
    { auto rr = __builtin_amdgcn_permlane32_swap(__float_as_uint(v), __float_as_uint(v), false, false); v = __uint_as_float(rr[0]) + __uint_as_float(rr[1]); }
    return v;
}
DI float wave_max(float v) {
#pragma unroll
    for (int o = 1; o < 64; o <<= 1) v = fmaxf(v, __shfl_xor(v, o));
    return v;
}
DI float silu_f(float g) { return g * __builtin_amdgcn_rcpf(1.f + __builtin_amdgcn_exp2f(-g * LOG2E)); }

namespace pg8 {
constexpr int BM = 256, BK = 64, HALF = 128, HTB = HALF * BK * 2, STAGE_BYTES = 8 * HTB, NXCD = 8, WGM = 8;
__host__ __device__ __forceinline__ int lds_byte(int r, int c) { const int st = (r >> 4) * 2 + (c >> 5), rr = r & 15, cc = c & 31, ob = rr * 64 + cc * 2; return st * 1024 + (ob ^ (((ob >> 9) & 1) << 5)); }
__host__ __device__ __forceinline__ void stage_rc(int b, int& R, int& C) { const int st = b / 1024, sb = b % 1024, swz = sb ^ (((sb >> 9) & 1) << 5); R = (st >> 1) * 16 + swz / 64; C = (st & 1) * 32 + (swz % 64) / 2; }
__host__ __device__ __forceinline__ int perm32(int rho) { const int n = rho >> 4, i = rho & 15; return 8 * (i >> 2) + 4 * n + (i & 3); }
struct Unit { int pm, pn; };
struct Gemm { const bf16_t* A; const bf16_t* Bt; int M, N, K; };
struct StaticOrder {
    int nM, nN, nwg, G, c;
    __device__ void init(int M, int N, int G_, int c_) { nM = M / BM; nN = N / BM; nwg = nM * nN; G = G_; c = c_; }
    __device__ bool next(int i, Unit& u) const {
        const long L = (long)i * G + c; if (L >= nwg) return false;
        int wgid = (int)L; { const int q = nwg / NXCD, r = nwg % NXCD, xcd = wgid % NXCD, off = wgid / NXCD; wgid = (xcd < r ? xcd * (q + 1) : r * (q + 1) + (xcd - r) * q) + off; }
        const int nig = WGM * nN, gid = wgid / nig, fm = gid * WGM, gsz = (nM - fm) < WGM ? (nM - fm) : WGM;
        u.pm = fm + ((wgid % nig) % gsz); u.pn = (wgid % nig) / gsz; return true;
    }
};
template <class Epi, class Sched>
__device__ __forceinline__ void gemm_phase(LAS unsigned char* lds, const Gemm g, const Sched& S, const Epi& E) {
    const int tid = threadIdx.x, wid = __builtin_amdgcn_readfirstlane(tid >> 6), lane = tid & 63, wr = wid >> 2, wc = wid & 3, fr = lane & 15, fq = lane >> 4;
    const int K = g.K, nt = K / BK;
    unsigned voffA[2], voffB[2];
#pragma unroll
    for (int i = 0; i < 2; ++i) { int R, C; stage_rc(tid * 16 + i * 8192, R, C); const int Rb = 64 * (R >> 5) + perm32(R & 31);
        voffA[i] = (unsigned)(R * K + C) * 2u; voffB[i] = (unsigned)(Rb * K + C) * 2u; }
    const size_t kstep = (size_t)(BK * 2);
    const size_t hstep = (size_t)HALF * K * 2;
    const size_t hstepB = (size_t)32 * K * 2;
    const size_t tstep = 2 * hstep;
    const unsigned ldsw = (unsigned)wid * 1024u;
    const int aoff = lds_byte(wr * 64 + fr, fq * 8), boff = lds_byte(wc * 32 + fr, fq * 8);
#define PG8_SA(b, h) (((b) * 2 + (h)) * HTB)
#define PG8_SB(b, h) ((4 + (b) * 2 + (h)) * HTB)
#define PG8_STAGE(bufoff, gbase, voff) do { _Pragma("unroll") for (int _i = 0; _i < 2; ++_i) \
        __builtin_amdgcn_global_load_lds((const unsigned*)((const char*)(gbase) + (voff)[_i]), (LAS unsigned*)(lds + (bufoff) + ldsw + _i * 8192), 16, 0, 0); } while (0)
#define PG8_LDA(dst, b, h) do { _Pragma("unroll") for (int m = 0; m < 4; ++m) _Pragma("unroll") for (int k = 0; k < 2; ++k) dst[m][k] = *(const LAS bf16x8*)(lds + PG8_SA(b, h) + aoff + m * 2048 + k * 1024); } while (0)
#define PG8_LDB(dst, b, h) do { _Pragma("unroll") for (int n = 0; n < 2; ++n) _Pragma("unroll") for (int k = 0; k < 2; ++k) dst[n][k] = *(const LAS bf16x8*)(lds + PG8_SB(b, h) + boff + n * 2048 + k * 1024); } while (0)
#define PG8_MMA(ai, bj, At, Bt) do { __builtin_amdgcn_s_setprio(1); _Pragma("unroll") for (int m = 0; m < 4; ++m) _Pragma("unroll") for (int n = 0; n < 2; ++n) _Pragma("unroll") for (int k = 0; k < 2; ++k) \
        acc[ai][bj][m][n] = __builtin_amdgcn_mfma_f32_16x16x32_bf16(Bt[n][k], At[m][k], acc[ai][bj][m][n], 0, 0, 0); __builtin_amdgcn_s_setprio(0); } while (0)
#define PG8_WAIT_V(n) asm volatile("s_waitcnt vmcnt(" #n ")" ::: "memory")
#define PG8_WAIT_L(n) asm volatile("s_waitcnt lgkmcnt(" #n ")" ::: "memory")
#define PG8_BAR __builtin_amdgcn_s_barrier()
#define PG8_SCHED __builtin_amdgcn_sched_barrier(0)
    Unit cur, nxt; int ui = 0;
    if (!S.next(0, cur)) return;
    f32x4 acc[2][2][4][2];
#pragma unroll
    for (int a = 0; a < 2; ++a)
#pragma unroll
        for (int b = 0; b < 2; ++b)
#pragma unroll
            for (int m = 0; m < 4; ++m)
#pragma unroll
                for (int n = 0; n < 2; ++n) acc[a][b][m][n] = (f32x4){0.f, 0.f, 0.f, 0.f};
    bf16x8 At[4][2], B0[2][2], B1[2][2];
    const char* cA = (const char*)g.A + (size_t)cur.pm * tstep; const char* cB = (const char*)g.Bt + (size_t)cur.pn * tstep;
    PG8_STAGE(PG8_SB(0, 0), cB, voffB); PG8_STAGE(PG8_SB(0, 1), cB + hstepB, voffB); PG8_STAGE(PG8_SA(0, 0), cA, voffA); PG8_STAGE(PG8_SA(0, 1), cA + hstep, voffA);
    if (wr == 1) PG8_BAR;
    PG8_WAIT_V(2); PG8_BAR;
    PG8_STAGE(PG8_SB(1, 0), cB + kstep, voffB); PG8_STAGE(PG8_SA(1, 0), cA + kstep, voffA); PG8_STAGE(PG8_SB(1, 1), cB + hstepB + kstep, voffB);
    PG8_WAIT_V(6); PG8_BAR;
    for (;;) {
        const bool has_next = S.next(ui + 1, nxt);
        const char* nA = has_next ? (const char*)g.A + (size_t)nxt.pm * tstep : cA; const char* nB = has_next ? (const char*)g.Bt + (size_t)nxt.pn * tstep : cB;
        for (int t = 0; t < nt; t += 2) {
            const bool last = (t == nt - 2);
            const char* a1 = cA + (size_t)(t + 1) * kstep;
            const char* a2 = last ? nA : cA + (size_t)(t + 2) * kstep; const char* b2 = last ? nB : cB + (size_t)(t + 2) * kstep;
            const char* a3 = a2 + kstep; const char* b3 = b2 + kstep;
            PG8_LDB(B0, 0, 0); PG8_LDB(B1, 0, 1); PG8_SCHED; PG8_LDA(At, 0, 0); PG8_STAGE(PG8_SA(1, 1), a1 + hstep, voffA);
            PG8_WAIT_V(8); PG8_WAIT_L(0); PG8_BAR; PG8_MMA(0, 0, At, B0); PG8_MMA(0, 1, At, B1); PG8_BAR; PG8_SCHED;
            PG8_LDA(At, 0, 1); PG8_STAGE(PG8_SB(0, 0), b2, voffB); PG8_STAGE(PG8_SB(0, 1), b2 + hstepB, voffB); PG8_STAGE(PG8_SA(0, 0), a2, voffA);
            PG8_WAIT_V(8); PG8_WAIT_L(0); PG8_BAR; PG8_MMA(1, 0, At, B0); PG8_MMA(1, 1, At, B1); PG8_BAR; PG8_SCHED;
            PG8_LDB(B0, 1, 0); PG8_LDB(B1, 1, 1); PG8_SCHED; PG8_LDA(At, 1, 0); PG8_STAGE(PG8_SA(0, 1), a2 + hstep, voffA);
            PG8_WAIT_V(8); PG8_WAIT_L(0); PG8_BAR; PG8_MMA(0, 0, At, B0); PG8_MMA(0, 1, At, B1); PG8_BAR; PG8_SCHED;
            PG8_LDA(At, 1, 1); PG8_STAGE(PG8_SB(1, 0), b3, voffB); PG8_STAGE(PG8_SB(1, 1), b3 + hstepB, voffB); PG8_STAGE(PG8_SA(1, 0), a3, voffA);
            PG8_WAIT_V(8); PG8_WAIT_L(0); PG8_BAR; PG8_MMA(1, 0, At, B0); PG8_MMA(1, 1, At, B1); PG8_BAR; PG8_SCHED;
        }
        if (wr == 0) PG8_BAR;
        E(acc, cur, wr, wc, fr, fq);
        if (!has_next) break;
#pragma unroll
        for (int a = 0; a < 2; ++a)
#pragma unroll
            for (int b = 0; b < 2; ++b)
#pragma unroll
                for (int m = 0; m < 4; ++m)
#pragma unroll
                    for (int n = 0; n < 2; ++n) acc[a][b][m][n] = (f32x4){0.f, 0.f, 0.f, 0.f};
        cur = nxt; cA = nA; cB = nB; ++ui;
        if (wr == 1) PG8_BAR;
    }
    PG8_WAIT_V(0);
    PG8_BAR;
#undef PG8_SA
#undef PG8_SB
#undef PG8_STAGE
#undef PG8_LDA
#undef PG8_LDB
#undef PG8_MMA
#undef PG8_WAIT_V
#undef PG8_WAIT_L
#undef PG8_BAR
#undef PG8_SCHED
}
}

struct EpiIn {
    unsigned char* ws;
    const float *qnw, *knw, *rope;
    DI void operator()(const f32x4 (&acc)[2][2][4][2], const pg8::Unit& u, int wr, int wc, int fr, int fq) const {
        const int grp = u.pn >> 2, sub = u.pn & 3;
        const int row0 = u.pm * 256 + wr * 64 + fr;
        const int b = row0 >> 12, i0 = row0 & 4095;
        const int head = sub * 2 + (wc >> 1), bh = b * NH + head;
        const int dcol = 64 * (wc & 1) + 8 * fq;
        if (grp == 3 || grp == 7) {
            bf16_t* base = (bf16_t*)(ws + WS_G) + (size_t)row0 * DM + (grp == 7 ? 1024 : 0) + sub * 256 + 64 * wc + 8 * fq;
#pragma unroll
            for (int ai = 0; ai < 2; ++ai)
#pragma unroll
                for (int m = 0; m < 4; ++m)
#pragma unroll
                    for (int bj = 0; bj < 2; ++bj) { const f32x4 v0 = acc[ai][bj][m][0], v1 = acc[ai][bj][m][1]; u32x4 w;
                        w.x = cvt_pk_bf16(silu_f(v0[0]), silu_f(v0[1])); w.y = cvt_pk_bf16(silu_f(v0[2]), silu_f(v0[3]));
                        w.z = cvt_pk_bf16(silu_f(v1[0]), silu_f(v1[1])); w.w = cvt_pk_bf16(silu_f(v1[2]), silu_f(v1[3]));
                        *(u32x4*)(base + (size_t)(ai * 128 + m * 16) * DM + bj * 32) = w; }
        } else if (grp == 4 || grp == 5) {
            const float* nw = (grp == 4) ? qnw : knw;
            const float sc = (grp == 4) ? LOG2E * 0.125f : 1.f;
            const size_t eoff = (grp == 4) ? ((size_t)bh * SEQ + i0) * HD + dcol : ((size_t)bh * TPAD + 64 + i0) * HD + dcol;
            bf16_t* base = (bf16_t*)(ws + ((grp == 4) ? WS_DFQ : WS_DFK)) + eoff;
            f32x4 wv[2][2];
#pragma unroll
            for (int bj = 0; bj < 2; ++bj)
#pragma unroll
                for (int n = 0; n < 2; ++n) wv[bj][n] = *(const f32x4*)(nw + 32 * bj + 8 * fq + 4 * n);
#pragma unroll
            for (int am = 0; am < 4; ++am) { const int ai = am >> 1;
                f32x4 csn[4][2][2];
#pragma unroll
                for (int m = 2 * (am & 1); m < 2 * (am & 1) + 2; ++m) { const float* rt = rope + (size_t)(NMETA + i0 + ai * 128 + m * 16) * 16;
#pragma unroll
                    for (int n = 0; n < 2; ++n) { csn[m][n][0] = *(const f32x4*)(rt + 4 * n); csn[m][n][1] = *(const f32x4*)(rt + 8 + 4 * n); } }
#pragma unroll
                for (int m = 2 * (am & 1); m < 2 * (am & 1) + 2; ++m) {
                    f32x4 v[2][2]; float ss = 0.f;
#pragma unroll
                    for (int bj = 0; bj < 2; ++bj)
#pragma unroll
                        for (int n = 0; n < 2; ++n) { v[bj][n] = acc[ai][bj][m][n]; const f32x4 q = v[bj][n] * v[bj][n]; ss += (q[0] + q[1]) + (q[2] + q[3]); }
                    ss += __shfl_xor(ss, 16); ss += __shfl_xor(ss, 32);
                    const float rstd = __builtin_amdgcn_rsqf(ss * (1.f / 64.f) + RMS_EPS);
#pragma unroll
                    for (int bj = 0; bj < 2; ++bj)
#pragma unroll
                        for (int n = 0; n < 2; ++n) v[bj][n] = v[bj][n] * rstd * wv[bj][n];
#pragma unroll
                    for (int n = 0; n < 2; ++n) { const f32x4 cs = csn[m][n][0], sn = csn[m][n][1];
                        f32x4 pr; pr[0] = __shfl_xor(v[0][n][0], 16); pr[1] = __shfl_xor(v[0][n][1], 16); pr[2] = __shfl_xor(v[0][n][2], 16); pr[3] = __shfl_xor(v[0][n][3], 16);
                        const f32x4 x = v[0][n];
                        if (fq == 0) v[0][n] = x * cs - pr * sn; else if (fq == 1) v[0][n] = x * cs + pr * sn; }
#pragma unroll
                    for (int bj = 0; bj < 2; ++bj) { const f32x4 v0 = v[bj][0] * sc, v1 = v[bj][1] * sc; u32x4 w;
                        w.x = cvt_pk_bf16(v0[0], v0[1]); w.y = cvt_pk_bf16(v0[2], v0[3]); w.z = cvt_pk_bf16(v1[0], v1[1]); w.w = cvt_pk_bf16(v1[2], v1[3]);
                        *(u32x4*)(base + (size_t)(ai * 128 + m * 16) * HD + bj * 32) = w; }
                }
            }
        } else {
            const float sc = (grp == 0) ? -LOG2E * 0.08838834764831845f : 1.f;
            const size_t eoff = (grp == 0) ? ((size_t)bh * SEQ + i0) * HD + dcol : ((size_t)bh * TPAD + 64 + i0) * HD + dcol;
            size_t aoff = WS_SBQ; if (grp == 1) aoff = WS_SBK; if (grp == 2) aoff = WS_SBV; if (grp == 6) aoff = WS_DFV;
            bf16_t* base = (bf16_t*)(ws + aoff) + eoff;
#pragma unroll
            for (int ai = 0; ai < 2; ++ai)
#pragma unroll
                for (int m = 0; m < 4; ++m)
#pragma unroll
                    for (int bj = 0; bj < 2; ++bj) { const f32x4 v0 = acc[ai][bj][m][0] * sc, v1 = acc[ai][bj][m][1] * sc; u32x4 w;
                        w.x = cvt_pk_bf16(v0[0], v0[1]); w.y = cvt_pk_bf16(v0[2], v0[3]); w.z = cvt_pk_bf16(v1[0], v1[1]); w.w = cvt_pk_bf16(v1[2], v1[3]);
                        *(u32x4*)(base + (size_t)(ai * 128 + m * 16) * HD + bj * 32) = w; }
        }
    }
};
struct EpiOut {
    const float* x; float* out;
    DI void operator()(const f32x4 (&acc)[2][2][4][2], const pg8::Unit& u, int wr, int wc, int fr, int fq) const {
        const size_t off0 = (size_t)(u.pm * 256 + wr * 64 + fr) * DM + u.pn * 256 + 64 * wc + 8 * fq;
#pragma unroll
        for (int ai = 0; ai < 2; ++ai) {
            f32x4 xv[4][2][2];
#pragma unroll
            for (int m = 0; m < 4; ++m)
#pragma unroll
                for (int bj = 0; bj < 2; ++bj) { const size_t off = off0 + (size_t)(ai * 128 + m * 16) * DM + bj * 32;
                    xv[m][bj][0] = *(const f32x4*)(x + off); xv[m][bj][1] = *(const f32x4*)(x + off + 4); }
#pragma unroll
            for (int m = 0; m < 4; ++m)
#pragma unroll
                for (int bj = 0; bj < 2; ++bj) { const size_t off = off0 + (size_t)(ai * 128 + m * 16) * DM + bj * 32;
                    *(f32x4*)(out + off) = xv[m][bj][0] + acc[ai][bj][m][0]; *(f32x4*)(out + off + 4) = xv[m][bj][1] + acc[ai][bj][m][1]; }
        }
    }
};

namespace att {
constexpr int SHM_V = 16384, SHM_K = 16384;
constexpr int L_V = 0, L_K = 2 * SHM_V, L_Q = 65536, L_WS = 131072 + 4096, L_CTRL = 131072 + 4096 + 2048;
#define KSWZ(row, colB) ((row) * 256 + ((colB) ^ (((row) & 7) << 4)))
#define SBAR() __builtin_amdgcn_sched_barrier(0)
DI int v_st(int k, int c) { const int kk = (k & ~0xC) | ((k & 4) << 1) | ((k & 8) >> 1); return ((kk >> 3) * 4 + (c >> 5)) * 512 + ((kk & 7) * 32 + (c & 31)) * 2; }
DI int v_rd_base(int lane) { return ((lane & 3) << 3) | (((lane >> 2) & 3) << 6) | (((lane >> 4) & 1) << 5) | (((lane >> 5) & 1) << 8); }
constexpr int v_rd_off(int d0, int ks, int half) { return d0 * 512 + ks * 4096 + half * 2048; }
DI int crow(int r, int hi) { return (r & 3) + 8 * (r >> 2) + 4 * hi; }

DI void glds16s(const void* sbase, unsigned voff, unsigned lds_dst) {
    unsigned keep;
    asm volatile("s_mov_b32 %0, m0\n\ts_mov_b32 m0, %3\n\ts_nop 0\n\tglobal_load_lds_dwordx4 %1, %2\n\ts_mov_b32 m0, %0" : "=&s"(keep) : "v"(voff), "s"(sbase), "s"(lds_dst) : "memory");
}
template <int NK>
DI void qkt(f32x16& p0, f32x16& p1, LAS const unsigned char* Kb, int r32, int hi, int cofs, const bf16x8* qr, float cinit) {
#pragma unroll
    for (int r = 0; r < 16; ++r) { p0[r] = cinit; p1[r] = cinit; }
    LAS const unsigned char* kb[4];
#pragma unroll
    for (int dd = 0; dd < 4; ++dd) kb[dd] = Kb + KSWZ(r32, (dd * 16 + hi * 8) * 2) + cofs;
#pragma unroll
    for (int d0 = 0; d0 < NK; ++d0) { LAS const unsigned char* a = kb[d0 & 3] + (d0 >> 2) * 128;
        const bf16x8 b0 = *(LAS const bf16x8*)a, b1 = *(LAS const bf16x8*)(a + 32 * 256);
        p0 = __builtin_amdgcn_mfma_f32_32x32x16_bf16(b0, qr[d0], p0, 0, 0, 0);
        p1 = __builtin_amdgcn_mfma_f32_32x32x16_bf16(b1, qr[d0], p1, 0, 0, 0); }
}
DI void qkt_lq(f32x16& p0, f32x16& p1, LAS const unsigned char* Kb, LAS const unsigned char* Qw, int r32, int hi, int cofs) {
    f32x16 z;
#pragma unroll
    for (int r = 0; r < 16; ++r) z[r] = 0.f;
    bf16x8 b0[2], b1[2], q[2];
#define LDF(d0_, sl) do { const int off = KSWZ(r32, ((d0_) * 16 + hi * 8) * 2) + cofs; \
        b0[sl] = *(LAS const bf16x8*)(Kb + off); b1[sl] = *(LAS const bf16x8*)(Kb + off + 32 * 256); q[sl] = *(LAS const bf16x8*)(Qw + off); } while (0)
    LDF(0, 0);
#pragma unroll
    for (int d0 = 0; d0 < 4; ++d0) {
        if (d0 < 3) LDF(d0 + 1, (d0 + 1) & 1);
        if (d0 == 0) { p0 = __builtin_amdgcn_mfma_f32_32x32x16_bf16(b0[0], q[0], z, 0, 0, 0); p1 = __builtin_amdgcn_mfma_f32_32x32x16_bf16(b1[0], q[0], z, 0, 0, 0); }
        else { p0 = __builtin_amdgcn_mfma_f32_32x32x16_bf16(b0[d0 & 1], q[d0 & 1], p0, 0, 0, 0); p1 = __builtin_amdgcn_mfma_f32_32x32x16_bf16(b1[d0 & 1], q[d0 & 1], p1, 0, 0, 0); }
    }
#undef LDF
}
DI void pv_tile(f32x16* o, int vb0, bf16x8 pa0, bf16x8 pa1, bf16x8 pa2, bf16x8 pa3) {
#define TRRD(dst, off) asm volatile("ds_read_b64_tr_b16 %0, %1 offset:%2" : "=&v"(dst) : "v"(vb0), "i"(off) : "memory")
#define PV_D0(d0) do { s16x4 l0, l1, l2, l3, h0, h1, h2, h3; constexpr int b_ = v_rd_off(d0, 0, 0); \
        TRRD(l0, b_); TRRD(h0, b_ + 2048); TRRD(l1, b_ + 4096); TRRD(h1, b_ + 6144); TRRD(l2, b_ + 8192); TRRD(h2, b_ + 10240); TRRD(l3, b_ + 12288); TRRD(h3, b_ + 14336); \
        asm volatile("s_waitcnt lgkmcnt(0)" ::: "memory"); SBAR(); \
        o[d0] = __builtin_amdgcn_mfma_f32_32x32x16_bf16(pa0, (bf16x8){l0[0], l0[1], l0[2], l0[3], h0[0], h0[1], h0[2], h0[3]}, o[d0], 0, 0, 0); \
        o[d0] = __builtin_amdgcn_mfma_f32_32x32x16_bf16(pa1, (bf16x8){l1[0], l1[1], l1[2], l1[3], h1[0], h1[1], h1[2], h1[3]}, o[d0], 0, 0, 0); \
        o[d0] = __builtin_amdgcn_mfma_f32_32x32x16_bf16(pa2, (bf16x8){l2[0], l2[1], l2[2], l2[3], h2[0], h2[1], h2[2], h2[3]}, o[d0], 0, 0, 0); \
        o[d0] = __builtin_amdgcn_mfma_f32_32x32x16_bf16(pa3, (bf16x8){l3[0], l3[1], l3[2], l3[3], h3[0], h3[1], h3[2], h3[3]}, o[d0], 0, 0, 0); } while (0)
    PV_D0(0); PV_D0(1); PV_D0(2); PV_D0(3);
#undef PV_D0
#undef TRRD
}
DI void pv_tile_db(f32x16* o, int vb0, bf16x8 pa0, bf16x8 pa1, bf16x8 pa2, bf16x8 pa3) {
#define TRRD(dst, off) asm volatile("ds_read_b64_tr_b16 %0, %1 offset:%2" : "=&v"(dst) : "v"(vb0), "i"(off) : "memory")
#define VLD(S, d0) do { constexpr int b_ = v_rd_off(d0, 0, 0); TRRD(S##l0, b_); TRRD(S##h0, b_ + 2048); TRRD(S##l1, b_ + 4096); TRRD(S##h1, b_ + 6144); \
        TRRD(S##l2, b_ + 8192); TRRD(S##h2, b_ + 10240); TRRD(S##l3, b_ + 12288); TRRD(S##h3, b_ + 14336); } while (0)
#define LWAIT(n) do { asm volatile("s_waitcnt lgkmcnt(" #n ")" ::: "memory"); SBAR(); } while (0)
#define VF(l, h) (bf16x8){l[0], l[1], l[2], l[3], h[0], h[1], h[2], h[3]}
#define PVX(S, d0) do { \
        o[d0] = __builtin_amdgcn_mfma_f32_32x32x16_bf16(pa0, VF(S##l0, S##h0), o[d0], 0, 0, 0); o[d0] = __builtin_amdgcn_mfma_f32_32x32x16_bf16(pa1, VF(S##l1, S##h1), o[d0], 0, 0, 0); \
        o[d0] = __builtin_amdgcn_mfma_f32_32x32x16_bf16(pa2, VF(S##l2, S##h2), o[d0], 0, 0, 0); o[d0] = __builtin_amdgcn_mfma_f32_32x32x16_bf16(pa3, VF(S##l3, S##h3), o[d0], 0, 0, 0); SBAR(); } while (0)
    s16x4 Al0, Al1, Al2, Al3, Ah0, Ah1, Ah2, Ah3, Bl0, Bl1, Bl2, Bl3, Bh0, Bh1, Bh2, Bh3;
    VLD(A, 0);
    VLD(B, 1); LWAIT(8); PVX(A, 0);
    VLD(A, 2); LWAIT(8); PVX(B, 1);
    VLD(B, 3); LWAIT(8); PVX(A, 2);
    LWAIT(0); PVX(B, 3);
#undef PVX
#undef VF
#undef LWAIT
#undef VLD
#undef TRRD
}
DI void pack_p(const f32x16& p0, const f32x16& p1, bf16x8& pa0, bf16x8& pa1, bf16x8& pa2, bf16x8& pa3) {
#define PK4(P, B_, OUT) do { u32x4 w = {cvt_pk_bf16(P[B_+0], P[B_+1]), cvt_pk_bf16(P[B_+2], P[B_+3]), cvt_pk_bf16(P[B_+4], P[B_+5]), cvt_pk_bf16(P[B_+6], P[B_+7])}; \
        OUT = __builtin_bit_cast(bf16x8, w); } while (0)
    PK4(p0, 0, pa0); PK4(p0, 8, pa1); PK4(p1, 0, pa2); PK4(p1, 8, pa3);
#undef PK4
}
struct Ptrs { const bf16_t *sbQ, *sbK, *sbV, *dfQ, *dfK, *dfV, *G; bf16_t* MIX; const float* subw; float lam, boff; };

DI void pv_tile2(f32x16* o, int vb0, const bf16x8* pa, const bf16x8* pb) {
#define TRRD(dst, off) asm volatile("ds_read_b64_tr_b16 %0, %1 offset:%2" : "=&v"(dst) : "v"(vb0), "i"(off) : "memory")
#define PV_D0(d0) do { s16x4 l0, l1, l2, l3, h0, h1, h2, h3; constexpr int b_ = v_rd_off(d0, 0, 0); \
        TRRD(l0, b_); TRRD(h0, b_ + 2048); TRRD(l1, b_ + 4096); TRRD(h1, b_ + 6144); TRRD(l2, b_ + 8192); TRRD(h2, b_ + 10240); TRRD(l3, b_ + 12288); TRRD(h3, b_ + 14336); \
        asm volatile("s_waitcnt lgkmcnt(0)" ::: "memory"); SBAR(); \
        const bf16x8 v0 = (bf16x8){l0[0], l0[1], l0[2], l0[3], h0[0], h0[1], h0[2], h0[3]}, v1 = (bf16x8){l1[0], l1[1], l1[2], l1[3], h1[0], h1[1], h1[2], h1[3]}; \
        const bf16x8 v2 = (bf16x8){l2[0], l2[1], l2[2], l2[3], h2[0], h2[1], h2[2], h2[3]}, v3 = (bf16x8){l3[0], l3[1], l3[2], l3[3], h3[0], h3[1], h3[2], h3[3]}; \
        o[d0] = __builtin_amdgcn_mfma_f32_32x32x16_bf16(pa[0], v0, o[d0], 0, 0, 0); o[4 + d0] = __builtin_amdgcn_mfma_f32_32x32x16_bf16(pb[0], v0, o[4 + d0], 0, 0, 0); \
        o[d0] = __builtin_amdgcn_mfma_f32_32x32x16_bf16(pa[1], v1, o[d0], 0, 0, 0); o[4 + d0] = __builtin_amdgcn_mfma_f32_32x32x16_bf16(pb[1], v1, o[4 + d0], 0, 0, 0); \
        o[d0] = __builtin_amdgcn_mfma_f32_32x32x16_bf16(pa[2], v2, o[d0], 0, 0, 0); o[4 + d0] = __builtin_amdgcn_mfma_f32_32x32x16_bf16(pb[2], v2, o[4 + d0], 0, 0, 0); \
        o[d0] = __builtin_amdgcn_mfma_f32_32x32x16_bf16(pa[3], v3, o[d0], 0, 0, 0); o[4 + d0] = __builtin_amdgcn_mfma_f32_32x32x16_bf16(pb[3], v3, o[4 + d0], 0, 0, 0); } while (0)
    PV_D0(0); PV_D0(1); PV_D0(2); PV_D0(3);
#undef PV_D0
#undef TRRD
}
template <int DF, int VAR = 0>
DI void attn_unit(const Ptrs& P, int bh, int qb, LAS unsigned char* lds) {
    int tid = threadIdx.x; asm volatile("" : "+v"(tid));
    const int wid = __builtin_amdgcn_readfirstlane(tid >> 6), lane = tid & 63, r32 = lane & 31, hi = lane >> 5;
    constexpr int QROWS = 256, INCL = DF ? 1 : 0, NO = DF ? 8 : 4;
    const int i0 = qb * QROWS;
    const int qlo = i0 + 32 * wid, b = bh >> 3, h = bh & 7;
    const bf16_t* Qh = (DF ? P.dfQ : P.sbQ) + (size_t)bh * SEQ * HD;
    const bf16_t* Kh = (DF ? P.dfK : P.sbK) + (size_t)bh * TPAD * HD;
    const bf16_t* Vh = (DF ? P.dfV : P.sbV) + (size_t)bh * TPAD * HD;
    const int NT = (i0 + QROWS) / 64 + 1;
    LAS unsigned char* V_lds = lds + L_V; LAS unsigned char* K_lds = lds + L_K;
    LAS float* wsf = (LAS float*)(lds + L_WS) + wid * 64;
    LAS unsigned* eflag = (LAS unsigned*)(lds + L_CTRL) + 16;
    bf16x8 qr[8];
    LAS unsigned char* Q_lds = lds + L_Q + wid * 8192;
    if (DF) {
#pragma unroll
        for (int i = 0; i < 8; ++i) { const int p = i * 64 + lane, row = p >> 4, cs = p & 15, c = cs ^ (row & 7);
            glds16s(Qh + (size_t)qlo * HD, (unsigned)(row * HD + c * 8) * 2u, (unsigned)__builtin_amdgcn_readfirstlane((unsigned)(uintptr_t)Q_lds + i * 1024)); }
    } else {
#pragma unroll
        for (int d0 = 0; d0 < 8; ++d0) qr[d0] = *(const bf16x8*)(Qh + (size_t)(qlo + r32) * HD + d0 * 16 + hi * 8);
    }
    const int vbase = (int)(unsigned)(uintptr_t)V_lds + v_rd_base(lane);
    unsigned koff[2], voff[2];
#pragma unroll
    for (int i = 0; i < 2; ++i) { const int p = (i * 8 + wid) * 64 + lane;
        { const int row = p >> 4, cs = p & 15, c = cs ^ (row & 7); koff[i] = (unsigned)(row * HD + c * 8) * 2u; }
        { const int st = p >> 5, kk = (st >> 2) * 8 + ((p & 31) >> 2), k = kk  , c = (st & 3) * 32 + (p & 3) * 8; voff[i] = (unsigned)(k * HD + c) * 2u; } }
    const unsigned ldsK0 = (unsigned)(uintptr_t)K_lds + wid * 1024, ldsV0 = (unsigned)(uintptr_t)V_lds + wid * 1024;
#define DMA(kt_, bf) do { const char* kb_ = (const char*)(Kh + (size_t)(kt_) * 64 * HD); const char* vb_ = (const char*)(Vh + (size_t)(kt_) * 64 * HD); \
        _Pragma("unroll") for (int _i = 0; _i < 2; ++_i) { \
            glds16s(kb_, koff[_i], (unsigned)__builtin_amdgcn_readfirstlane(ldsK0 + (bf) * SHM_K + _i * 8192)); \
            glds16s(vb_, voff[_i], (unsigned)__builtin_amdgcn_readfirstlane(ldsV0 + (bf) * SHM_V + _i * 8192)); } } while (0)
    f32x16 o[NO];
#pragma unroll
    for (int d = 0; d < NO; ++d)
#pragma unroll
        for (int r = 0; r < 16; ++r) o[d][r] = 0.f;
    bool wdone = false;
    float carry = 1.f, lsum0 = 0.f, lsum1 = 0.f;
    DMA(DF ? 0 : NT - 1, 0);
    asm volatile("s_waitcnt vmcnt(0)" ::: "memory");
    if (!DF) {
#pragma unroll
        for (int d0 = 0; d0 < 8; ++d0) asm volatile("" : "+v"(qr[d0]));
    }
    __syncthreads();
    for (int it = 0; it < NT; ++it) {
        const int kt = DF ? it : NT - 1 - it, buf = it & 1;
        if (it + 1 < NT && !(VAR & 2)) DMA(DF ? kt + 1 : kt - 1, buf ^ 1);
        const int j0 = 64 * (kt - 1);
        const bool act = (kt == 0) || (j0 < qlo + 31 + INCL);
        const bool need_mask = (kt == 0) || (j0 + 63 >= qlo + INCL);
        if (act && !(VAR & 4) && !(!DF && SB_EARLY_EXIT && wdone)) {
            const int thi = qlo + r32 - j0 + INCL - 4 * hi;
            if (DF) {
                LAS const unsigned char* Kb = K_lds + buf * SHM_K;
                const int vb0 = vbase + buf * SHM_V;
                f32x16 s0a, s0b, s1a, s1b;
                qkt_lq(s0a, s0b, Kb, Q_lds, r32, hi, 0);
                SBAR();
                {
                    f32x16 z;
#pragma unroll
                    for (int r = 0; r < 16; ++r) z[r] = 0.f;
                    bf16x8 kb0[2], kb1[2], qf[2];
#define LDF(d0_, sl) do { const int off = KSWZ(r32, ((d0_) * 16 + hi * 8) * 2) + 128; \
                        kb0[sl] = *(LAS const bf16x8*)(Kb + off); kb1[sl] = *(LAS const bf16x8*)(Kb + off + 32 * 256); qf[sl] = *(LAS const bf16x8*)(Q_lds + off); } while (0)
                    LDF(0, 0);
#pragma unroll
                    for (int d0 = 0; d0 < 4; ++d0) {
                        if (d0 < 3) LDF(d0 + 1, (d0 + 1) & 1);
                        SBAR();
                        if (d0 == 0) s1a = __builtin_amdgcn_mfma_f32_32x32x16_bf16(kb0[0], qf[0], z, 0, 0, 0); else s1a = __builtin_amdgcn_mfma_f32_32x32x16_bf16(kb0[d0 & 1], qf[d0 & 1], s1a, 0, 0, 0);
#pragma unroll
                        for (int j = 0; j < 4; ++j) if (!(VAR & 32)) s0a[4 * d0 + j] = __builtin_amdgcn_exp2f(s0a[4 * d0 + j]);
                        SBAR();
                        if (d0 == 0) s1b = __builtin_amdgcn_mfma_f32_32x32x16_bf16(kb1[0], qf[0], z, 0, 0, 0); else s1b = __builtin_amdgcn_mfma_f32_32x32x16_bf16(kb1[d0 & 1], qf[d0 & 1], s1b, 0, 0, 0);
#pragma unroll
                        for (int j = 0; j < 4; ++j) if (!(VAR & 32)) s0b[4 * d0 + j] = __builtin_amdgcn_exp2f(s0b[4 * d0 + j]);
                        SBAR();
                    }
#undef LDF
                }
#define DF_MASK(PA, PB) do { if (need_mask) { if (kt == 0) { _Pragma("unroll") for (int r = 0; r < 16; ++r) { PA[r] = 0.f; if (r < 8) PB[r] = 0.f; } } \
                    else { _Pragma("unroll") for (int r = 0; r < 16; ++r) { const int c = (r & 3) + 8 * (r >> 2); if (c >= thi) PA[r] = 0.f; if (c + 32 >= thi) PB[r] = 0.f; } } } } while (0)
                bf16x8 pa[4];
                { DF_MASK(s0a, s0b); float ps = 0.f;
                  { float t_[16];
                    _Pragma("unroll") for (int r = 0; r < 16; ++r) t_[r] = s0a[r] + s0b[r];
                    _Pragma("unroll") for (int w_ = 8; w_ >= 1; w_ >>= 1) { _Pragma("unroll") for (int r = 0; r < w_; ++r) t_[r] += t_[r + w_]; }
                    ps = t_[0]; }
                  asm volatile("" : "+v"(ps)); lsum0 += ps; pack_p(s0a, s0b, pa[0], pa[1], pa[2], pa[3]); }
                SBAR();
#define TRRD(dst, off) asm volatile("ds_read_b64_tr_b16 %0, %1 offset:%2" : "=&v"(dst) : "v"(vb0), "i"(off) : "memory")
#define VFRAG(l, h) (bf16x8){l[0], l[1], l[2], l[3], h[0], h[1], h[2], h[3]}
#define EXP2(X, B_) do { if (!(VAR & 32)) { X[B_] = __builtin_amdgcn_exp2f(X[B_]); X[B_ + 1] = __builtin_amdgcn_exp2f(X[B_ + 1]); } } while (0)
#define VLD(S, d0) do { constexpr int b_ = v_rd_off(d0, 0, 0); TRRD(S##l0, b_); TRRD(S##h0, b_ + 2048); TRRD(S##l1, b_ + 4096); TRRD(S##h1, b_ + 6144); \
        TRRD(S##l2, b_ + 8192); TRRD(S##h2, b_ + 10240); TRRD(S##l3, b_ + 12288); TRRD(S##h3, b_ + 14336); } while (0)
#define LWAIT(n) do { asm volatile("s_waitcnt lgkmcnt(" #n ")" ::: "memory"); SBAR(); } while (0)
#define PVA(S, d0, SX, EB) do { \
        o[d0] = __builtin_amdgcn_mfma_f32_32x32x16_bf16(pa[0], VFRAG(S##l0, S##h0), o[d0], 0, 0, 0); EXP2(SX, EB); SBAR(); \
        o[d0] = __builtin_amdgcn_mfma_f32_32x32x16_bf16(pa[1], VFRAG(S##l1, S##h1), o[d0], 0, 0, 0); EXP2(SX, EB + 2); SBAR(); \
        o[d0] = __builtin_amdgcn_mfma_f32_32x32x16_bf16(pa[2], VFRAG(S##l2, S##h2), o[d0], 0, 0, 0); EXP2(SX, EB + 4); SBAR(); \
        o[d0] = __builtin_amdgcn_mfma_f32_32x32x16_bf16(pa[3], VFRAG(S##l3, S##h3), o[d0], 0, 0, 0); EXP2(SX, EB + 6); SBAR(); } while (0)
#define PVB(S, d0) do { \
        o[4 + d0] = __builtin_amdgcn_mfma_f32_32x32x16_bf16(pb[0], VFRAG(S##l0, S##h0), o[4 + d0], 0, 0, 0); \
        o[4 + d0] = __builtin_amdgcn_mfma_f32_32x32x16_bf16(pb[1], VFRAG(S##l1, S##h1), o[4 + d0], 0, 0, 0); \
        o[4 + d0] = __builtin_amdgcn_mfma_f32_32x32x16_bf16(pb[2], VFRAG(S##l2, S##h2), o[4 + d0], 0, 0, 0); \
        o[4 + d0] = __builtin_amdgcn_mfma_f32_32x32x16_bf16(pb[3], VFRAG(S##l3, S##h3), o[4 + d0], 0, 0, 0); SBAR(); } while (0)
                s16x4 Al0, Al1, Al2, Al3, Ah0, Ah1, Ah2, Ah3, Bl0, Bl1, Bl2, Bl3, Bh0, Bh1, Bh2, Bh3;
                __builtin_amdgcn_s_setprio(1);
                if (!(VAR & 16)) {
                VLD(A, 0);
                VLD(B, 1); LWAIT(8); PVA(A, 0, s1a, 0);
                VLD(A, 2); LWAIT(8); PVA(B, 1, s1a, 8);
                VLD(B, 3); LWAIT(8); PVA(A, 2, s1b, 0);
                VLD(A, 0); LWAIT(8); PVA(B, 3, s1b, 8);
                } else { _Pragma("unroll") for (int r = 0; r < 16; r += 2) { EXP2(s1a, r); EXP2(s1b, r); } if (!(VAR & 8)) VLD(A, 0); }
                bf16x8 pb[4];
                { DF_MASK(s1a, s1b); float ps = 0.f;
                  { float t_[16];
                    _Pragma("unroll") for (int r = 0; r < 16; ++r) t_[r] = s1a[r] + s1b[r];
                    _Pragma("unroll") for (int w_ = 8; w_ >= 1; w_ >>= 1) { _Pragma("unroll") for (int r = 0; r < w_; ++r) t_[r] += t_[r + w_]; }
                    ps = t_[0]; }
                  asm volatile("" : "+v"(ps)); lsum1 += ps; pack_p(s1a, s1b, pb[0], pb[1], pb[2], pb[3]); }
                SBAR();
                if (!(VAR & 8)) {
                VLD(B, 1); LWAIT(8); PVB(A, 0);
                VLD(A, 2); LWAIT(8); PVB(B, 1);
                VLD(B, 3); LWAIT(8); PVB(A, 2);
                LWAIT(0); PVB(B, 3);
                }
                __builtin_amdgcn_s_setprio(0);
#undef VLD
#undef LWAIT
#undef PVA
#undef PVB
#undef PVA_D0
#undef PVB_D0
#undef TRRD
#undef VFRAG
#undef EXP2
#undef DF_MASK
            } else {
                f32x16 p0, p1;
                qkt<8>(p0, p1, K_lds + buf * SHM_K, r32, hi, 0, qr, 0.f);
#pragma unroll
                for (int r = 0; r < 16; ++r) { p0[r] = 1.f - __builtin_amdgcn_rcpf(1.f + __builtin_amdgcn_exp2f(p0[r])); p1[r] = 1.f - __builtin_amdgcn_rcpf(1.f + __builtin_amdgcn_exp2f(p1[r])); }
                if (need_mask) {
                    if (kt == 0) {
#pragma unroll
                        for (int r = 0; r < 16; ++r) { p0[r] = 1.f; if (r < 8) p1[r] = 1.f; }
                    } else {
#pragma unroll
                        for (int r = 0; r < 16; ++r) { const int c = (r & 3) + 8 * (r >> 2);
                            if (c >= thi) p0[r] = 1.f;
                            if (c + 32 >= thi) p1[r] = 1.f; }
                    }
                }
                float Glo[2][4], Ghi[2][4];
#pragma unroll
                for (int g = 0; g < 4; ++g) {
                    const float g0 = (p0[4 * g] * p0[4 * g + 1]) * (p0[4 * g + 2] * p0[4 * g + 3]);
                    const float g1 = (p1[4 * g] * p1[4 * g + 1]) * (p1[4 * g + 2] * p1[4 * g + 3]);
                    auto r0 = __builtin_amdgcn_permlane32_swap(__float_as_uint(g0), __float_as_uint(g0), false, false);
                    auto r1 = __builtin_amdgcn_permlane32_swap(__float_as_uint(g1), __float_as_uint(g1), false, false);
                    Glo[0][g] = __uint_as_float(r0[0]); Ghi[0][g] = __uint_as_float(r0[1]); Glo[1][g] = __uint_as_float(r1[0]); Ghi[1][g] = __uint_as_float(r1[1]);
                }
                float run = carry;
#pragma unroll
                for (int x = 1; x >= 0; --x)
#pragma unroll
                    for (int g = 3; g >= 0; --g) {
                        const float e1 = run; run *= Ghi[x][g]; const float e0 = run; run *= Glo[x][g];
                        float e = hi ? e1 : e0;
#pragma unroll
                        for (int j = 3; j >= 0; --j) {
                            if (x == 0) { const float en = p0[4 * g + j] * e; p0[4 * g + j] = e - en; e = en; }
                            else        { const float en = p1[4 * g + j] * e; p1[4 * g + j] = e - en; e = en; }
                        }
                    }
                carry = run;
                bf16x8 pa0, pa1, pa2, pa3;
                pack_p(p0, p1, pa0, pa1, pa2, pa3);
                __builtin_amdgcn_s_setprio(1);
                pv_tile_db(o, vbase + buf * SHM_V, pa0, pa1, pa2, pa3);
                __builtin_amdgcn_s_setprio(0);
            }
        }
        if (!DF && SB_EARLY_EXIT) { wdone = __all(carry == 0.f); if (lane == 0) eflag[(it & 1) * 8 + wid] = wdone ? 1u : 0u; }
        asm volatile("s_waitcnt vmcnt(0)" ::: "memory");
        __syncthreads();
        if (!DF && SB_EARLY_EXIT) { const u32x4 f0 = *(LAS const u32x4*)(eflag + (it & 1) * 8), f1 = *(LAS const u32x4*)(eflag + (it & 1) * 8 + 4);
            if (((f0.x & f0.y) & (f0.z & f0.w)) & ((f1.x & f1.y) & (f1.z & f1.w))) break; }
    }
#undef DMA
    int lane_e = lane; asm volatile("" : "+v"(lane_e));
    constexpr int SPITCH = 272;
    LAS unsigned char* stg = lds + wid * 8704;
    if (DF) {
        { auto rr = __builtin_amdgcn_permlane32_swap(__float_as_uint(lsum0), __float_as_uint(lsum0), false, false); lsum0 = __uint_as_float(rr[0]) + __uint_as_float(rr[1]); }
        { auto rr = __builtin_amdgcn_permlane32_swap(__float_as_uint(lsum1), __float_as_uint(lsum1), false, false); lsum1 = __uint_as_float(rr[0]) + __uint_as_float(rr[1]); }
        wsf[lane] = hi ? lsum1 : lsum0;
        asm volatile("s_waitcnt lgkmcnt(0)" ::: "memory");
        const float lam = P.lam;
        float ss[16];
#pragma unroll
        for (int r = 0; r < 16; ++r) { const float rl0 = __builtin_amdgcn_rcpf(wsf[crow(r, hi)]), rl1 = lam * __builtin_amdgcn_rcpf(wsf[32 + crow(r, hi)]); float q = 0.f;
#pragma unroll
            for (int d = 0; d < 4; ++d) { const float v = o[d][r] * rl0 - o[NO - 4 + d][r] * rl1; o[d][r] = v; q += v * v; }
            ss[r] = q; }
#pragma unroll
        for (int r = 0; r < 16; ++r) {
            ss[r] += __int_as_float(__builtin_amdgcn_update_dpp(0, __float_as_int(ss[r]), 0xB1, 0xF, 0xF, true));
            ss[r] += __int_as_float(__builtin_amdgcn_update_dpp(0, __float_as_int(ss[r]), 0x4E, 0xF, 0xF, true));
            ss[r] += __int_as_float(__builtin_amdgcn_update_dpp(0, __float_as_int(ss[r]), 0x141, 0xF, 0xF, true));
            ss[r] += __int_as_float(__builtin_amdgcn_update_dpp(0, __float_as_int(ss[r]), 0x140, 0xF, 0xF, true));
            ss[r] += __shfl_xor(ss[r], 16);
            ss[r] = __builtin_amdgcn_rsqf(ss[r] * (1.f / 128.f) + SUBLN_EPS) * (1.f - LAM_INIT);
        }
#pragma unroll
        for (int d = 0; d < 4; ++d) { const float w = P.subw[d * 32 + r32];
#pragma unroll
            for (int r = 0; r < 16; ++r) o[d][r] = o[d][r] * ss[r] * w; }
    }
    {
#pragma unroll
        for (int d = 0; d < 4; ++d)
#pragma unroll
            for (int r = 0; r < 16; ++r) { const float v = o[d][r]; const float vn = __int_as_float(__builtin_amdgcn_update_dpp(0, __float_as_int(v), 0xB1, 0xF, 0xF, true));
                if ((r32 & 1) == 0) *(LAS unsigned*)(stg + crow(r, hi) * SPITCH + (d * 32 + r32) * 2) = cvt_pk_bf16(v, vn); }
        asm volatile("s_waitcnt lgkmcnt(0)" ::: "memory");
        const size_t grow0 = (size_t)(b * SEQ + qlo); const int gcol0 = (DF ? 1024 : 0) + h * HD;
        u32x4 gv[8];
#pragma unroll
        for (int it = 0; it < 8; ++it) { const int c = it * 64 + lane_e, row = c >> 4, ch = c & 15; gv[it] = *(const u32x4*)(P.G + (grow0 + row) * DM + gcol0 + ch * 8); }
#pragma unroll
        for (int it = 0; it < 8; ++it) { const int c = it * 64 + lane_e, row = c >> 4, ch = c & 15;
            const u32x4 ov = *(LAS const u32x4*)(stg + row * SPITCH + ch * 16);
            const size_t goff = (grow0 + row) * DM + gcol0 + ch * 8;
            u32x4 w;
            w.x = cvt_pk_bf16(bf_lo(ov.x) * bf_lo(gv[it].x), bf_hi(ov.x) * bf_hi(gv[it].x)); w.y = cvt_pk_bf16(bf_lo(ov.y) * bf_lo(gv[it].y), bf_hi(ov.y) * bf_hi(gv[it].y));
            w.z = cvt_pk_bf16(bf_lo(ov.z) * bf_lo(gv[it].z), bf_hi(ov.z) * bf_hi(gv[it].z)); w.w = cvt_pk_bf16(bf_lo(ov.w) * bf_lo(gv[it].w), bf_hi(ov.w) * bf_hi(gv[it].w));
            if (!(VAR & 1)) *(u32x4*)(P.MIX + goff) = w; }
    }
}

#undef KSWZ
#undef SBAR
}

#define XB_TMO      128
#define XB_XCNT(j)  (256  + 64 * (j))
#define XB_XSUB(j)  (1280 + 64 * (j))
#define XB_XGEN(j)  (2304 + 64 * (j))
#define XB_TOP      3328
#define XB_TOPGEN   3392
#define XCD_BAR_WORDS 3456
#define XB_SPIN_CAP (1u << 18)
DI unsigned xb_ld(unsigned* p)              { return __hip_atomic_load(p, __ATOMIC_RELAXED, __HIP_MEMORY_SCOPE_AGENT); }
DI unsigned xb_add(unsigned* p, unsigned v) { return __hip_atomic_fetch_add(p, v, __ATOMIC_RELAXED, __HIP_MEMORY_SCOPE_AGENT); }
DI unsigned xb_xcc_id() { return (unsigned)__builtin_amdgcn_s_getreg((3 << 11) | 20) & 0xFu; }
#define XB_SPIN(cond, bar) do { unsigned _sp = 0; while (cond) { __builtin_amdgcn_s_sleep(1); \
    if ((++_sp & 255u) == 0u) { if (xb_ld(&(bar)[XB_TMO])) break; if (_sp > XB_SPIN_CAP) { atomicAdd(&(bar)[XB_TMO], 1u); break; } } } } while (0)
struct XcdBarrier { unsigned* bar; unsigned x; volatile LAS unsigned* st; };
DI XcdBarrier xcd_barrier_post(unsigned* bar, volatile LAS unsigned* st) {
    XcdBarrier b; b.bar = bar; b.x = xb_xcc_id(); b.st = st;
    if (threadIdx.x == 0) (void)xb_add(&bar[XB_XCNT(b.x)], 1u);
    return b;
}
DI void xcd_barrier_complete(unsigned* bar, unsigned x, unsigned& nloc, unsigned& nx) {
    const unsigned G = gridDim.x * gridDim.y * gridDim.z;
    unsigned sum, cnt, mine, sp = 0u;
    for (;;) {
        sum = 0u; cnt = 0u; mine = 0u;
#pragma unroll
        for (unsigned j = 0; j < 16; ++j) { const unsigned c = xb_ld(&bar[XB_XCNT(j)]); sum += c; cnt += (c > 0u) ? 1u : 0u; mine = (j == x) ? c : mine; }
        if (sum == G) break;
        __builtin_amdgcn_s_sleep(1);
        if ((++sp & 255u) == 0u) { if (xb_ld(&bar[XB_TMO])) break; if (sp > XB_SPIN_CAP) { atomicAdd(&bar[XB_TMO], 1u); break; } }
    }
    nloc = mine > 0u ? mine : 1u; nx = cnt > 0u ? cnt : 1u;
}
DI void xcd_barrier(const XcdBarrier& b) {
    asm volatile("s_waitcnt vmcnt(0)" ::: "memory");
    __syncthreads();
    if (threadIdx.x == 0) {
        unsigned* bar = b.bar;
        __builtin_amdgcn_s_waitcnt(0);
        unsigned nloc = b.st[0], nx = b.st[1];
        if (nloc == 0u) { xcd_barrier_complete(bar, b.x, nloc, nx); b.st[0] = nloc; b.st[1] = nx; }
        const unsigned old = xb_add(&bar[XB_XSUB(b.x)], 1u);
        const unsigned gen = old / nloc;
        if (old + 1u == (gen + 1u) * nloc) {
            __builtin_amdgcn_fence(__ATOMIC_RELEASE, "agent");
            asm volatile("s_waitcnt vmcnt(0)" ::: "memory");
            const unsigned og = xb_add(&bar[XB_TOP], 1u);
            const unsigned tg = og / nx;
            if (og + 1u == (tg + 1u) * nx) xb_add(&bar[XB_TOPGEN], 1u);
            else XB_SPIN(xb_ld(&bar[XB_TOPGEN]) == tg, bar);
            __builtin_amdgcn_fence(__ATOMIC_ACQUIRE, "agent");
            xb_add(&bar[XB_XGEN(b.x)], 1u);
            asm volatile("s_waitcnt vmcnt(0)" ::: "memory");
        } else {
            XB_SPIN(xb_ld(&bar[XB_XGEN(b.x)]) == gen, bar);
            __builtin_amdgcn_fence(__ATOMIC_ACQUIRE, "agent");
            asm volatile("s_waitcnt vmcnt(0)" ::: "memory");
        }
    }
    __syncthreads();
}

DI void p0_transpose_item(const float* W, int K, int N, bf16_t* WT, LAS float* scr, int item, int lane) {
    const int nblk = N / 32, kb = item / nblk, nb = item % nblk, k0 = 64 * kb, n0 = 32 * nb;
    f32x4 wv[8];
#pragma unroll
    for (int i = 0; i < 8; ++i) wv[i] = *(const f32x4*)(W + (size_t)(k0 + 8 * i + (lane >> 3)) * N + n0 + 4 * (lane & 7));
#pragma unroll
    for (int i = 0; i < 8; ++i) { LAS float* d = scr + (8 * i + (lane >> 3)) * 33 + 4 * (lane & 7); d[0] = wv[i][0]; d[1] = wv[i][1]; d[2] = wv[i][2]; d[3] = wv[i][3]; }
    asm volatile("s_waitcnt lgkmcnt(0)" ::: "memory");
    const int c = lane & 7;
#pragma unroll
    for (int j = 0; j < 4; ++j) { const int n = (lane >> 3) + 8 * j; const LAS float* s = scr + (8 * c) * 33 + n;
        u32x4 o; o.x = cvt_pk_bf16(s[0 * 33], s[1 * 33]); o.y = cvt_pk_bf16(s[2 * 33], s[3 * 33]); o.z = cvt_pk_bf16(s[4 * 33], s[5 * 33]); o.w = cvt_pk_bf16(s[6 * 33], s[7 * 33]);
        *(u32x4*)(WT + (size_t)(n0 + n) * K + k0 + 8 * c) = o; }
    asm volatile("s_waitcnt lgkmcnt(0)" ::: "memory");
}
DI void sincos_d(double a, double& s, double& c) {
    const double k = __builtin_rint(a * 0.63661977236758134308);
    const double y = (a - k * 1.57079632679489655800) - k * 6.123233995736766e-17;
    const double y2 = y * y;
    double sp = -1.0 / 1307674368000.0; sp = sp * y2 + 1.0 / 6227020800.0; sp = sp * y2 - 1.0 / 39916800.0; sp = sp * y2 + 1.0 / 362880.0; sp = sp * y2 - 1.0 / 5040.0; sp = sp * y2 + 1.0 / 120.0; sp = sp * y2 - 1.0 / 6.0; sp = sp * y2 + 1.0;
    const double sy = sp * y;
    double cp = 1.0 / 20922789888000.0; cp = cp * y2 - 1.0 / 87178291200.0; cp = cp * y2 + 1.0 / 479001600.0; cp = cp * y2 - 1.0 / 3628800.0; cp = cp * y2 + 1.0 / 40320.0; cp = cp * y2 - 1.0 / 720.0; cp = cp * y2 + 1.0 / 24.0; cp = cp * y2 - 0.5; cp = cp * y2 + 1.0;
    const int q = ((int)k) & 3;
    s = (q == 0) ? sy : (q == 1) ? cp : (q == 2) ? -sy : -cp;
    c = (q == 0) ? cp : (q == 1) ? -sy : (q == 2) ? -cp : sy;
}
DI int meta_col(int c64) { const int grp = c64 >> 4, c = c64 & 15; const int base = (grp == 0) ? 1024 : (grp == 1) ? 2048 : (grp == 2) ? 5120 : 6144; return base + c * 64; }

struct Args { const float* in[12]; float* out; unsigned char* ws; int ph_lo, ph_hi, coop, pad; };

__global__ void __launch_bounds__(512, 2) hybrid_fwd(Args args) {
    extern __shared__ __attribute__((aligned(16))) unsigned char lds_raw[];
    LAS unsigned char* lds = (LAS unsigned char*)lds_raw;
    const int tid = threadIdx.x, lane = tid & 63, wave = __builtin_amdgcn_readfirstlane(tid >> 6);
    const int G = gridDim.x, bx = blockIdx.x;
    const int gw = bx * 8 + wave, NGW = G * 8;
    unsigned char* ws = args.ws;
    const float* x = args.in[0]; const float* meta = args.in[1]; const float* norm_w = args.in[2]; const float* w_in = args.in[3];
    const float* qnw = args.in[4]; const float* knw = args.in[5]; const float* lq1 = args.in[6]; const float* lk1 = args.in[7];
    const float* lq2 = args.in[8]; const float* lk2 = args.in[9]; const float* subw = args.in[10]; const float* w_out = args.in[11];
    float* ctlf = (float*)(ws + WS_CTL); unsigned* ctlu = (unsigned*)(ws + WS_CTL);
    float* rope = (float*)(ws + WS_ROPE); float* mpart = (float*)(ws + WS_MPART);
    bf16_t* WinT = (bf16_t*)(ws + WS_WIN); bf16_t* WoutT = (bf16_t*)(ws + WS_WOUT); bf16_t* XN = (bf16_t*)(ws + WS_XN);
    bf16_t* Gt = (bf16_t*)(ws + WS_G); bf16_t* MIX = (bf16_t*)(ws + WS_MIX);
    bf16_t* sbQ = (bf16_t*)(ws + WS_SBQ); bf16_t* sbK = (bf16_t*)(ws + WS_SBK); bf16_t* sbV = (bf16_t*)(ws + WS_SBV);
    bf16_t* dfQ = (bf16_t*)(ws + WS_DFQ); bf16_t* dfK = (bf16_t*)(ws + WS_DFK); bf16_t* dfV = (bf16_t*)(ws + WS_DFV);
    const int lo = args.ph_lo, hi_ph = args.ph_hi;
#define IN(k) (lo <= (k) && (k) < hi_ph)
    { volatile LAS unsigned* st0 = (volatile LAS unsigned*)(lds + 138240); if (tid < 2) st0[tid] = 0u; }
    __syncthreads();
    const XcdBarrier xbar = xcd_barrier_post((unsigned*)(ws + WS_CTL) + 4096, (volatile LAS unsigned*)(lds + 138240));
#define SEAM(k) do { if (IN(k) && IN((k) + 1)) { if (args.coop == 2) cg::this_grid().sync(); else xcd_barrier(xbar); } } while (0)

    if (IN(0)) {
      for (int rep0 = 0; rep0 < REPS(0); ++rep0) {
        LAS float* scr = (LAS float*)(lds + wave * 16384);
        constexpr int I_IN = (DM / 64) * (INW / 32), I_OUT = (DM / 64) * (DM / 32);
        const int gw4 = bx * 4 + (wave & 3), NGW4 = G * 4;
        if (wave < 4) {
        for (int it = gw4; it < I_IN + I_OUT; it += NGW4) {
            if (it < I_IN) p0_transpose_item(w_in, DM, INW, WinT, scr, it, lane);
            else p0_transpose_item(w_out, DM, DM, WoutT, scr, it - I_IN, lane);
        }
        }
        {
            f32x4 nw[8];
#pragma unroll
            for (int j = 0; j < 8; ++j) nw[j] = ((const f32x4*)norm_w)[64 * j + lane];
            if (wave >= 4)
            for (int m = gw4; m < MROWS; m += 2 * NGW4) {
                const int m2 = m + NGW4;
                const bool has2 = m2 < MROWS;
                const f32x4* xr = (const f32x4*)(x + (size_t)m * DM) + lane;
                const f32x4* xr2 = (const f32x4*)(x + (size_t)(has2 ? m2 : m) * DM) + lane;
                f32x4 v[8], u[8]; float s = 0.f, s2 = 0.f;
#pragma unroll
                for (int j = 0; j < 8; ++j) { v[j] = xr[64 * j]; u[j] = xr2[64 * j]; }
#pragma unroll
                for (int j = 0; j < 8; ++j) { s += (v[j].x * v[j].x + v[j].y * v[j].y) + (v[j].z * v[j].z + v[j].w * v[j].w); s2 += (u[j].x * u[j].x + u[j].y * u[j].y) + (u[j].z * u[j].z + u[j].w * u[j].w); }
                const float rstd = __builtin_amdgcn_rsqf(wave_sum(s) * (1.f / DM) + RMS_EPS), rstd2 = __builtin_amdgcn_rsqf(wave_sum(s2) * (1.f / DM) + RMS_EPS);
                u32x2* o8 = (u32x2*)(XN + (size_t)m * DM) + lane;
#pragma unroll
                for (int j = 0; j < 8; ++j) { const f32x4 y = v[j] * rstd * nw[j]; u32x2 w; w.x = cvt_pk_bf16(y.x, y.y); w.y = cvt_pk_bf16(y.z, y.w); o8[64 * j] = w; }
                if (has2) { u32x2* o82 = (u32x2*)(XN + (size_t)m2 * DM) + lane;
#pragma unroll
                    for (int j = 0; j < 8; ++j) { const f32x4 y = u[j] * rstd2 * nw[j]; u32x2 w; w.x = cvt_pk_bf16(y.x, y.y); w.y = cvt_pk_bf16(y.z, y.w); o82[64 * j] = w; } }
            }
        }
        for (int it = gw; it < 64 * 32; it += NGW) {
            const int c64 = it & 63, kc = it >> 6, col = meta_col(c64) + lane, k0 = kc * 64;
            float ml[16];
            const float nwl = norm_w[k0 + lane];
#pragma unroll
            for (int r = 0; r < 16; ++r) ml[r] = meta[(size_t)r * DM + k0 + lane] * nwl;
            float acc[16];
#pragma unroll
            for (int r = 0; r < 16; ++r) acc[r] = 0.f;
            for (int kk = 0; kk < 64; ++kk) {
                const float w = w_in[(size_t)(k0 + kk) * INW + col];
#pragma unroll
                for (int r = 0; r < 16; ++r) acc[r] += __int_as_float(__builtin_amdgcn_readlane(__float_as_int(ml[r]), kk)) * w;
            }
#pragma unroll
            for (int r = 0; r < 16; ++r) mpart[(size_t)(kc * 16 + r) * 4096 + c64 * 64 + lane] = acc[r];
        }
        for (int idx = bx * 512 + tid; idx < (NMETA + SEQ) * 8; idx += G * 512) {
            const int pos = idx >> 3, f = idx & 7;
            const float invf = (f == 0) ? 1.0f : (f == 1) ? 0.1939227432012558f : (f == 2) ? 0.03760603070259094f : (f == 3) ? 0.007292664609849453f :
                               (f == 4) ? 0.0014142135623842478f : (f == 5) ? 0.00027424818836152554f : (f == 6) ? 5.318296098266728e-05f : 1.0313386155758053e-05f;
            const float ang = (float)pos * invf;
            double s, c; sincos_d((double)ang, s, c);
            rope[pos * 16 + f] = (float)c; rope[pos * 16 + 8 + f] = (float)s;
        }
        for (int idx = bx * 512 + tid; idx < 4 * NBH * 48 * 16; idx += G * 512) {
            const int arr = idx / (NBH * 48 * 16), r = idx % (NBH * 48 * 16), bhh = r / (48 * 16), ch = r % (48 * 16);
            size_t aoff = WS_SBK; if (arr == 1) aoff = WS_SBV; if (arr == 2) aoff = WS_DFK; if (arr == 3) aoff = WS_DFV;
            bf16_t* base = (bf16_t*)(ws + aoff);
            *(u32x4*)(base + (size_t)bhh * TPAD * HD + ch * 8) = (u32x4){0u, 0u, 0u, 0u};
        }
        if (bx == 0 && wave == 0) {
            const float s1 = wave_sum(lq1[lane] * lk1[lane]), s2 = wave_sum(lq2[lane] * lk2[lane]);
            const float mq = wave_max(fabsf(qnw[lane])), mk = wave_max(fabsf(knw[lane]));
            if (lane == 0) { ctlf[CW_LAM] = __expf(s1) - __expf(s2) + LAM_INIT; ctlf[CW_BOFF] = 8.f * mq * mk * LOG2E * 1.02f; }
            if (lane < 8) ctlu[CW_QUEUE + 64 * lane] = 0u;
        }
        if (rep0 + 1 < REPS(0)) __syncthreads();
      }
    }
    SEAM(0);
    if (PROBE_PHASE == 7) { for (int i = 0; i < 10; ++i) cg::this_grid().sync(); }

    if (IN(1)) {
        for (int it = gw; it < 64 * 16; it += NGW) {
            const int c64 = it & 63, r = it >> 6;
            float v = 0.f;
            for (int kc = 0; kc < 32; ++kc) v += mpart[(size_t)(kc * 16 + r) * 4096 + c64 * 64 + lane];
            float s = 0.f;
            for (int j = 0; j < 32; ++j) { const float mv = meta[(size_t)r * DM + j * 64 + lane]; s += mv * mv; }
            v *= __builtin_amdgcn_rsqf(wave_sum(s) * (1.f / DM) + RMS_EPS);
            const int grp = c64 >> 4, c = c64 & 15;
            if (grp == 2) {
                const float ss = wave_sum(v * v);
                v = v * __builtin_amdgcn_rsqf(ss * (1.f / 64.f) + RMS_EPS) * knw[lane];
                const float pr = __shfl_xor(v, 8);
                if (lane < 16) { const float cs = rope[r * 16 + (lane & 7)], sn = rope[r * 16 + 8 + (lane & 7)]; v = (lane < 8) ? v * cs - pr * sn : v * cs + pr * sn; }
            }
            size_t aoff = WS_SBK; if (grp == 1) aoff = WS_SBV; if (grp == 2) aoff = WS_DFK; if (grp == 3) aoff = WS_DFV;
            bf16_t* arr = (bf16_t*)(ws + aoff);
            const bf16_t hv = (bf16_t)(cvt_pk_bf16(v, v) & 0xffffu);
            for (int bb = 0; bb < BATCH; ++bb) arr[((size_t)(bb * NH + (c >> 1)) * TPAD + 48 + r) * HD + (c & 1) * 64 + lane] = hv;
        }
        pg8::Gemm g{XN, WinT, MROWS, INW, DM}; pg8::StaticOrder S; S.init(MROWS, INW, G, bx);
        EpiIn E{ws, qnw, knw, rope};
        pg8::gemm_phase<EpiIn, pg8::StaticOrder>(lds, g, S, E);
        if constexpr (PROBE_PHASE == 1) { cg::this_grid().sync(); pg8::gemm_phase<EpiIn, pg8::StaticOrder>(lds, g, S, E); }
    }
    SEAM(1);

    if (IN(2)) {
        att::Ptrs P{sbQ, sbK, sbV, dfQ, dfK, dfV, Gt, MIX, subw, ctlf[CW_LAM], ctlf[CW_BOFF]};
        LAS unsigned* ctrl = (LAS unsigned*)(lds + att::L_CTRL);
        const unsigned xcc = (unsigned)__builtin_amdgcn_s_getreg((3 << 11) | 20) & 7u;
        for (int rep = 0; rep < REPS(2); ++rep) {
        unsigned q = xcc, nxt = 0xffffffffu; int slot = 0;
#define QPOP(qstart) do { unsigned qq = (qstart), L_ = 256u; \
            for (int t = 0; t < 8; ++t) { L_ = atomicAdd(ctlu + CW_QUEUE + 64 * qq, 1u); if (L_ < 256u) break; qq = (qq + 1) & 7u; } \
            nxt = (L_ < 256u) ? ((qq << 8) | L_) : 0xffffffffu; } while (0)
        if (tid == 0) QPOP(q);
        for (;;) {
            if (tid == 0) ctrl[slot] = nxt;
            __syncthreads();
            const unsigned v = (unsigned)__builtin_amdgcn_readfirstlane((int)ctrl[slot]);
            slot ^= 1;
            if (v == 0xffffffffu) break;
            q = v >> 8; const int L = (int)(v & 255u), w = L & 127, pr = w >> 5, wi = w & 31, qb = 15 - (wi >> 1), bh = (int)q * 8 + 2 * pr + (wi & 1);
            if (tid == 0) QPOP(q);
            if (L < 128) att::attn_unit<1>(P, bh, qb, lds);
            else att::attn_unit<0>(P, bh, qb, lds);
        }
#undef QPOP
        if (rep + 1 < REPS(2)) { cg::this_grid().sync(); if (bx == 0 && tid < 8) ctlu[CW_QUEUE + 64 * tid] = 0u; __threadfence(); cg::this_grid().sync(); }
        }
    }
    SEAM(2);

    if (IN(3)) {
        pg8::Gemm g{MIX, WoutT, MROWS, DM, DM}; pg8::StaticOrder S; S.init(MROWS, DM, G, bx);
        EpiOut E{x, args.out};
        pg8::gemm_phase<EpiOut, pg8::StaticOrder>(lds, g, S, E);
        if constexpr (PROBE_PHASE == 3) { cg::this_grid().sync(); pg8::gemm_phase<EpiOut, pg8::StaticOrder>(lds, g, S, E); }
    }
#undef IN
#undef SEAM
}

extern "C" void kernel_launch(void* const* d_in, const int* in_sizes, int n_in, void* d_out, int out_size, void* d_ws, size_t ws_size, hipStream_t stream) {
    static int grid = 0;
    if (grid == 0) {
        if (n_in != 12 || in_sizes[0] != MROWS * DM || out_size != MROWS * DM || ws_size < WS_END) { fprintf(stderr, "kernel_launch: unexpected shapes (n_in %d, ws %zu)\n", n_in, ws_size); grid = -1; return; }
        int dev = 0, cus = 0, per_cu = 0;
        (void)hipGetDevice(&dev); (void)hipDeviceGetAttribute(&cus, hipDeviceAttributeMultiprocessorCount, dev);
        if (hipFuncSetAttribute((const void*)hybrid_fwd, hipFuncAttributeMaxDynamicSharedMemorySize, LDS_BYTES) != hipSuccess) { fprintf(stderr, "kernel_launch: hipFuncSetAttribute failed\n"); grid = -1; return; }
        if (hipOccupancyMaxActiveBlocksPerMultiprocessor(&per_cu, (const void*)hybrid_fwd, 512, LDS_BYTES) != hipSuccess || per_cu < 1) per_cu = 1;
        (void)hipGetLastError();
        grid = cus > 0 ? cus * per_cu : 256;
    }
    if (grid < 0) return;
    if (hipMemsetAsync((char*)d_ws + WS_CTL, 0, 65536, stream) != hipSuccess) { fprintf(stderr, "kernel_launch: hipMemsetAsync failed\n"); return; }
    Args a{};
    for (int i = 0; i < 12; ++i) a.in[i] = (const float*)d_in[i];
    a.out = (float*)d_out; a.ws = (unsigned char*)d_ws; a.ph_lo = 0; a.ph_hi = 4; a.coop = 1; a.pad = 0;
    void* kargs[] = {&a};
    hipError_t e = hipLaunchCooperativeKernel((const void*)hybrid_fwd, dim3(grid), dim3(512), kargs, LDS_BYTES, stream);
    if (e != hipSuccess) fprintf(stderr, "kernel_launch: cooperative launch failed: %s (grid %d)\n", hipGetErrorString(e), grid);
}
```

```cpp
#include <hip/hip_runtime.h>
#include <hip/hip_cooperative_groups.h>
#include <cstdio>
#include <cstdint>
namespace cg = cooperative_groups;

#define LAS __attribute__((address_space(3)))
#define DI __device__ __forceinline__
typedef unsigned short bf16_t;
typedef short bf16x8 __attribute__((ext_vector_type(8)));
typedef short s16x4 __attribute__((ext_vector_type(4)));
typedef float f32x4 __attribute__((ext_vector_type(4)));
typedef float f32x16 __attribute__((ext_vector_type(16)));
typedef unsigned u32x4 __attribute__((ext_vector_type(4)));
typedef unsigned u32x2 __attribute__((ext_vector_type(2)));

constexpr int BATCH = 8, SEQ = 4096, DM = 2048, NMETA = 16, INW = 8192;
constexpr int MROWS = BATCH * SEQ;
constexpr int TPAD = SEQ + 64;
constexpr int NH = 8, HD = 128, NBH = BATCH * NH;
constexpr float RMS_EPS = 1e-6f, SUBLN_EPS = 1e-5f, LAM_INIT = 0.2f;
constexpr float LOG2E = 1.4426950408889634f;
constexpr bool SB_EARLY_EXIT = true;
#ifndef PROBE_PHASE
#define PROBE_PHASE (-1)
#endif
#ifndef PROBE_VAR
#define PROBE_VAR 1
#endif
#ifndef PROBE_REPS
#define PROBE_REPS 2
#endif
#define REPS(k) ((PROBE_PHASE == (k)) ? PROBE_REPS : 1)

constexpr size_t MiB = 1u << 20;
constexpr size_t WS_CTL = 0, WS_ROPE = 1 * MiB, WS_MPART = 2 * MiB, WS_WIN = 16 * MiB, WS_WOUT = 48 * MiB, WS_XN = 64 * MiB,
                 WS_G = 192 * MiB, WS_MIX = 320 * MiB, WS_SBQ = 448 * MiB, WS_SBK = 512 * MiB, WS_SBV = 578 * MiB,
                 WS_DFQ = 644 * MiB, WS_DFK = 708 * MiB, WS_DFV = 774 * MiB, WS_END = 840 * MiB;
constexpr int CW_LAM = 0, CW_BOFF = 1, CW_QUEUE = 64;

constexpr int LDS_BYTES = 147456;

DI unsigned cvt_pk_bf16(float lo, float hi) { unsigned r; asm volatile("v_cvt_pk_bf16_f32 %0, %1, %2" : "=v"(r) : "v"(lo), "v"(hi)); return r; }
DI float bf_lo(unsigned w) { return __uint_as_float(w << 16); }
DI float bf_hi(unsigned w) { return __uint_as_float(w & 0xffff0000u); }
DI float wave_sum(float v) {
    v += __int_as_float(__builtin_amdgcn_update_dpp(0, __float_as_int(v), 0xB1, 0xF, 0xF, true));
    v += __int_as_float(__builtin_amdgcn_update_dpp(0, __float_as_int(v), 0x4E, 0xF, 0xF, true));
    v += __int_as_float(__builtin_amdgcn_update_dpp(0, __float_as_int(v), 0x141, 0xF, 0xF, true));
    v += __int_as_float(__builtin_amdgcn_update_dpp(0, __float_as_int(v), 0x140, 0xF, 0xF, true));
    v += __shfl_xor(v, 16);
    { auto rr = __builtin_amdgcn_permlane32_swap(__float_as_uint(v), __float_as_uint(v), false, false); v = __uint_as_float(rr[0]) + __uint_as_float(rr[1]); }
    return v;
}
DI float wave_max(float v) {
#pragma unroll
    for (int o = 1; o < 64; o <<= 1) v = fmaxf(v, __shfl_xor(v, o));
    return v;
}
DI float silu_f(float g) { return g * __builtin_amdgcn_rcpf(1.f + __builtin_amdgcn_exp2f(-g * LOG2E)); }

namespace pg8 {
constexpr int BM = 256, BK = 64, HALF = 128, HTB = HALF * BK * 2, STAGE_BYTES = 8 * HTB, NXCD = 8, WGM = 8;
__host__ __device__ __forceinline__ int lds_byte(int r, int c) { const int st = (r >> 4) * 2 + (c >> 5), rr = r & 15, cc = c & 31, ob = rr * 64 + cc * 2; return st * 1024 + (ob ^ (((ob >> 9) & 1) << 5)); }
__host__ __device__ __forceinline__ void stage_rc(int b, int& R, int& C) { const int st = b / 1024, sb = b % 1024, swz = sb ^ (((sb >> 9) & 1) << 5); R = (st >> 1) * 16 + swz / 64; C = (st & 1) * 32 + (swz % 64) / 2; }
__host__ __device__ __forceinline__ int perm32(int rho) { const int n = rho >> 4, i = rho & 15; return 8 * (i >> 2) + 4 * n + (i & 3); }
struct Unit { int pm, pn; };
struct Gemm { const bf16_t* A; const bf16_t* Bt; int M, N, K; };
struct StaticOrder {
    int nM, nN, nwg, G, c;
    __device__ void init(int M, int N, int G_, int c_) { nM = M / BM; nN = N / BM; nwg = nM * nN; G = G_; c = c_; }
    __device__ bool next(int i, Unit& u) const {
        const long L = (long)i * G + c; if (L >= nwg) return false;
        int wgid = (int)L; { const int q = nwg / NXCD, r = nwg % NXCD, xcd = wgid % NXCD, off = wgid / NXCD; wgid = (xcd < r ? xcd * (q + 1) : r * (q + 1) + (xcd - r) * q) + off; }
        const int nig = WGM * nN, gid = wgid / nig, fm = gid * WGM, gsz = (nM - fm) < WGM ? (nM - fm) : WGM;
        u.pm = fm + ((wgid % nig) % gsz); u.pn = (wgid % nig) / gsz; return true;
    }
};
template <class Epi, class Sched>
__device__ __forceinline__ void gemm_phase(LAS unsigned char* lds, const Gemm g, const Sched& S, const Epi& E) {
    const int tid = threadIdx.x, wid = __builtin_amdgcn_readfirstlane(tid >> 6), lane = tid & 63, wr = wid >> 2, wc = wid & 3, fr = lane & 15, fq = lane >> 4;
    const int K = g.K, nt = K / BK;
    unsigned voffA[2], voffB[2];
#pragma unroll
    for (int i = 0; i < 2; ++i) { int R, C; stage_rc(tid * 16 + i * 8192, R, C); const int Rb = 64 * (R >> 5) + perm32(R & 31);
        voffA[i] = (unsigned)(R * K + C) * 2u; voffB[i] = (unsigned)(Rb * K + C) * 2u; }
    const size_t kstep = (size_t)(BK * 2);
    const size_t hstep = (size_t)HALF * K * 2;
    const size_t hstepB = (size_t)32 * K * 2;
    const size_t tstep = 2 * hstep;
    const unsigned ldsw = (unsigned)wid * 1024u;
    const int aoff = lds_byte(wr * 64 + fr, fq * 8), boff = lds_byte(wc * 32 + fr, fq * 8);
#define PG8_SA(b, h) (((b) * 2 + (h)) * HTB)
#define PG8_SB(b, h) ((4 + (b) * 2 + (h)) * HTB)
#define PG8_STAGE(bufoff, gbase, voff) do { _Pragma("unroll") for (int _i = 0; _i < 2; ++_i) \
        __builtin_amdgcn_global_load_lds((const unsigned*)((const char*)(gbase) + (voff)[_i]), (LAS unsigned*)(lds + (bufoff) + ldsw + _i * 8192), 16, 0, 0); } while (0)
#define PG8_LDA(dst, b, h) do { _Pragma("unroll") for (int m = 0; m < 4; ++m) _Pragma("unroll") for (int k = 0; k < 2; ++k) dst[m][k] = *(const LAS bf16x8*)(lds + PG8_SA(b, h) + aoff + m * 2048 + k * 1024); } while (0)
#define PG8_LDB(dst, b, h) do { _Pragma("unroll") for (int n = 0; n < 2; ++n) _Pragma("unroll") for (int k = 0; k < 2; ++k) dst[n][k] = *(const LAS bf16x8*)(lds + PG8_SB(b, h) + boff + n * 2048 + k * 1024); } while (0)
#define PG8_MMA(ai, bj, At, Bt) do { __builtin_amdgcn_s_setprio(1); _Pragma("unroll") for (int m = 0; m < 4; ++m) _Pragma("unroll") for (int n = 0; n < 2; ++n) _Pragma("unroll") for (int k = 0; k < 2; ++k) \
        acc[ai][bj][m][n] = __builtin_amdgcn_mfma_f32_16x16x32_bf16(Bt[n][k], At[m][k], acc[ai][bj][m][n], 0, 0, 0); __builtin_amdgcn_s_setprio(0); } while (0)
#define PG8_WAIT_V(n) asm volatile("s_waitcnt vmcnt(" #n ")" ::: "memory")
#define PG8_WAIT_L(n) asm volatile("s_waitcnt lgkmcnt(" #n ")" ::: "memory")
#define PG8_BAR __builtin_amdgcn_s_barrier()
#define PG8_SCHED __builtin_amdgcn_sched_barrier(0)
    Unit cur, nxt; int ui = 0;
    if (!S.next(0, cur)) return;
    f32x4 acc[2][2][4][2];
#pragma unroll
    for (int a = 0; a < 2; ++a)
#pragma unroll
        for (int b = 0; b < 2; ++b)
#pragma unroll
            for (int m = 0; m < 4; ++m)
#pragma unroll
                for (int n = 0; n < 2; ++n) acc[a][b][m][n] = (f32x4){0.f, 0.f, 0.f, 0.f};
    bf16x8 At[4][2], B0[2][2], B1[2][2];
    const char* cA = (const char*)g.A + (size_t)cur.pm * tstep; const char* cB = (const char*)g.Bt + (size_t)cur.pn * tstep;
    PG8_STAGE(PG8_SB(0, 0), cB, voffB); PG8_STAGE(PG8_SB(0, 1), cB + hstepB, voffB); PG8_STAGE(PG8_SA(0, 0), cA, voffA); PG8_STAGE(PG8_SA(0, 1), cA + hstep, voffA);
    if (wr == 1) PG8_BAR;
    PG8_WAIT_V(2); PG8_BAR;
    PG8_STAGE(PG8_SB(1, 0), cB + kstep, voffB); PG8_STAGE(PG8_SA(1, 0), cA + kstep, voffA); PG8_STAGE(PG8_SB(1, 1), cB + hstepB + kstep, voffB);
    PG8_WAIT_V(6); PG8_BAR;
    for (;;) {
        const bool has_next = S.next(ui + 1, nxt);
        const char* nA = has_next ? (const char*)g.A + (size_t)nxt.pm * tstep : cA; const char* nB = has_next ? (const char*)g.Bt + (size_t)nxt.pn * tstep : cB;
        for (int t = 0; t < nt; t += 2) {
            const bool last = (t == nt - 2);
            const char* a1 = cA + (size_t)(t + 1) * kstep;
            const char* a2 = last ? nA : cA + (size_t)(t + 2) * kstep; const char* b2 = last ? nB : cB + (size_t)(t + 2) * kstep;
            const char* a3 = a2 + kstep; const char* b3 = b2 + kstep;
            PG8_LDB(B0, 0, 0); PG8_LDB(B1, 0, 1); PG8_SCHED; PG8_LDA(At, 0, 0); PG8_STAGE(PG8_SA(1, 1), a1 + hstep, voffA);
            PG8_WAIT_V(8); PG8_WAIT_L(0); PG8_BAR; PG8_MMA(0, 0, At, B0); PG8_MMA(0, 1, At, B1); PG8_BAR; PG8_SCHED;
            PG8_LDA(At, 0, 1); PG8_STAGE(PG8_SB(0, 0), b2, voffB); PG8_STAGE(PG8_SB(0, 1), b2 + hstepB, voffB); PG8_STAGE(PG8_SA(0, 0), a2, voffA);
            PG8_WAIT_V(8); PG8_WAIT_L(0); PG8_BAR; PG8_MMA(1, 0, At, B0); PG8_MMA(1, 1, At, B1); PG8_BAR; PG8_SCHED;
            PG8_LDB(B0, 1, 0); PG8_LDB(B1, 1, 1); PG8_SCHED; PG8_LDA(At, 1, 0); PG8_STAGE(PG8_SA(0, 1), a2 + hstep, voffA);
            PG8_WAIT_V(8); PG8_WAIT_L(0); PG8_BAR; PG8_MMA(0, 0, At, B0); PG8_MMA(0, 1, At, B1); PG8_BAR; PG8_SCHED;
            PG8_LDA(At, 1, 1); PG8_STAGE(PG8_SB(1, 0), b3, voffB); PG8_STAGE(PG8_SB(1, 1), b3 + hstepB, voffB); PG8_STAGE(PG8_SA(1, 0), a3, voffA);
            PG8_WAIT_V(8); PG8_WAIT_L(0); PG8_BAR; PG8_MMA(1, 0, At, B0); PG8_MMA(1, 1, At, B1); PG8_BAR; PG8_SCHED;
        }
        if (wr == 0) PG8_BAR;
        E(acc, cur, wr, wc, fr, fq);
        if (!has_next) break;
#pragma unroll
        for (int a = 0; a < 2; ++a)
#pragma unroll
            for (int b = 0; b < 2; ++b)
#pragma unroll
                for (int m = 0; m < 4; ++m)
#pragma unroll
                    for (int n = 0; n < 2; ++n) acc[a][b][m][n] = (f32x4){0.f, 0.f, 0.f, 0.f};
        cur = nxt; cA = nA; cB = nB; ++ui;
        if (wr == 1) PG8_BAR;
    }
    PG8_WAIT_V(0);
    PG8_BAR;
#undef PG8_SA
#undef PG8_SB
#undef PG8_STAGE
#undef PG8_LDA
#undef PG8_LDB
#undef PG8_MMA
#undef PG8_WAIT_V
#undef PG8_WAIT_L
#undef PG8_BAR
#undef PG8_SCHED
}
}

struct EpiIn {
    unsigned char* ws;
    const float *qnw, *knw, *rope;
    DI void operator()(const f32x4 (&acc)[2][2][4][2], const pg8::Unit& u, int wr, int wc, int fr, int fq) const {
        const int grp = u.pn >> 2, sub = u.pn & 3;
        const int row0 = u.pm * 256 + wr * 64 + fr;
        const int b = row0 >> 12, i0 = row0 & 4095;
        const int head = sub * 2 + (wc >> 1), bh = b * NH + head;
        const int dcol = 64 * (wc & 1) + 8 * fq;
        if (grp == 3 || grp == 7) {
            bf16_t* base = (bf16_t*)(ws + WS_G) + (size_t)row0 * DM + (grp == 7 ? 1024 : 0) + sub * 256 + 64 * wc + 8 * fq;
#pragma unroll
            for (int ai = 0; ai < 2; ++ai)
#pragma unroll
                for (int m = 0; m < 4; ++m)
#pragma unroll
                    for (int bj = 0; bj < 2; ++bj) { const f32x4 v0 = acc[ai][bj][m][0], v1 = acc[ai][bj][m][1]; u32x4 w;
                        w.x = cvt_pk_bf16(silu_f(v0[0]), silu_f(v0[1])); w.y = cvt_pk_bf16(silu_f(v0[2]), silu_f(v0[3]));
                        w.z = cvt_pk_bf16(silu_f(v1[0]), silu_f(v1[1])); w.w = cvt_pk_bf16(silu_f(v1[2]), silu_f(v1[3]));
                        *(u32x4*)(base + (size_t)(ai * 128 + m * 16) * DM + bj * 32) = w; }
        } else if (grp == 4 || grp == 5) {
            const float* nw = (grp == 4) ? qnw : knw;
            const float sc = (grp == 4) ? LOG2E * 0.125f : 1.f;
            const size_t eoff = (grp == 4) ? ((size_t)bh * SEQ + i0) * HD + dcol : ((size_t)bh * TPAD + 64 + i0) * HD + dcol;
            bf16_t* base = (bf16_t*)(ws + ((grp == 4) ? WS_DFQ : WS_DFK)) + eoff;
            f32x4 wv[2][2];
#pragma unroll
            for (int bj = 0; bj < 2; ++bj)
#pragma unroll
                for (int n = 0; n < 2; ++n) wv[bj][n] = *(const f32x4*)(nw + 32 * bj + 8 * fq + 4 * n);
#pragma unroll
            for (int am = 0; am < 4; ++am) { const int ai = am >> 1;
                f32x4 csn[4][2][2];
#pragma unroll
                for (int m = 2 * (am & 1); m < 2 * (am & 1) + 2; ++m) { const float* rt = rope + (size_t)(NMETA + i0 + ai * 128 + m * 16) * 16;
#pragma unroll
                    for (int n = 0; n < 2; ++n) { csn[m][n][0] = *(const f32x4*)(rt + 4 * n); csn[m][n][1] = *(const f32x4*)(rt + 8 + 4 * n); } }
#pragma unroll
                for (int m = 2 * (am & 1); m < 2 * (am & 1) + 2; ++m) {
                    f32x4 v[2][2]; float ss = 0.f;
#pragma unroll
                    for (int bj = 0; bj < 2; ++bj)
#pragma unroll
                        for (int n = 0; n < 2; ++n) { v[bj][n] = acc[ai][bj][m][n]; const f32x4 q = v[bj][n] * v[bj][n]; ss += (q[0] + q[1]) + (q[2] + q[3]); }
                    ss += __shfl_xor(ss, 16); ss += __shfl_xor(ss, 32);
                    const float rstd = __builtin_amdgcn_rsqf(ss * (1.f / 64.f) + RMS_EPS);
#pragma unroll
                    for (int bj = 0; bj < 2; ++bj)
#pragma unroll
                        for (int n = 0; n < 2; ++n) v[bj][n] = v[bj][n] * rstd * wv[bj][n];
#pragma unroll
                    for (int n = 0; n < 2; ++n) { const f32x4 cs = csn[m][n][0], sn = csn[m][n][1];
                        f32x4 pr; pr[0] = __shfl_xor(v[0][n][0], 16); pr[1] = __shfl_xor(v[0][n][1], 16); pr[2] = __shfl_xor(v[0][n][2], 16); pr[3] = __shfl_xor(v[0][n][3], 16);
                        const f32x4 x = v[0][n];
                        if (fq == 0) v[0][n] = x * cs - pr * sn; else if (fq == 1) v[0][n] = x * cs + pr * sn; }
#pragma unroll
                    for (int bj = 0; bj < 2; ++bj) { const f32x4 v0 = v[bj][0] * sc, v1 = v[bj][1] * sc; u32x4 w;
                        w.x = cvt_pk_bf16(v0[0], v0[1]); w.y = cvt_pk_bf16(v0[2], v0[3]); w.z = cvt_pk_bf16(v1[0], v1[1]); w.w = cvt_pk_bf16(v1[2], v1[3]);
                        *(u32x4*)(base + (size_t)(ai * 128 + m * 16) * HD + bj * 32) = w; }
                }
            }
        } else {
            const float sc = (grp == 0) ? -LOG2E * 0.08838834764831845f : 1.f;
            const size_t eoff = (grp == 0) ? ((size_t)bh * SEQ + i0) * HD + dcol : ((size_t)bh * TPAD + 64 + i0) * HD + dcol;
            size_t aoff = WS_SBQ; if (grp == 1) aoff = WS_SBK; if (grp == 2) aoff = WS_SBV; if (grp == 6) aoff = WS_DFV;
            bf16_t* base = (bf16_t*)(ws + aoff) + eoff;
#pragma unroll
            for (int ai = 0; ai < 2; ++ai)
#pragma unroll
                for (int m = 0; m < 4; ++m)
#pragma unroll
                    for (int bj = 0; bj < 2; ++bj) { const f32x4 v0 = acc[ai][bj][m][0] * sc, v1 = acc[ai][bj][m][1] * sc; u32x4 w;
                        w.x = cvt_pk_bf16(v0[0], v0[1]); w.y = cvt_pk_bf16(v0[2], v0[3]); w.z = cvt_pk_bf16(v1[0], v1[1]); w.w = cvt_pk_bf16(v1[2], v1[3]);
                        *(u32x4*)(base + (size_t)(ai * 128 + m * 16) * HD + bj * 32) = w; }
        }
    }
};
struct EpiOut {
    const float* x; float* out;
    DI void operator()(const f32x4 (&acc)[2][2][4][2], const pg8::Unit& u, int wr, int wc, int fr, int fq) const {
        const size_t off0 = (size_t)(u.pm * 256 + wr * 64 + fr) * DM + u.pn * 256 + 64 * wc + 8 * fq;
#pragma unroll
        for (int ai = 0; ai < 2; ++ai) {
            f32x4 xv[4][2][2];
#pragma unroll
            for (int m = 0; m < 4; ++m)
#pragma unroll
                for (int bj = 0; bj < 2; ++bj) { const size_t off = off0 + (size_t)(ai * 128 + m * 16) * DM + bj * 32;
                    xv[m][bj][0] = *(const f32x4*)(x + off); xv[m][bj][1] = *(const f32x4*)(x + off + 4); }
#pragma unroll
            for (int m = 0; m < 4; ++m)
#pragma unroll
                for (int bj = 0; bj < 2; ++bj) { const size_t off = off0 + (size_t)(ai * 128 + m * 16) * DM + bj * 32;
                    *(f32x4*)(out + off) = xv[m][bj][0] + acc[ai][bj][m][0]; *(f32x4*)(out + off + 4) = xv[m][bj][1] + acc[ai][bj][m][1]; }
        }
    }
};

namespace att {
constexpr int SHM_V = 16384, SHM_K = 16384;
constexpr int L_V = 0, L_K = 2 * SHM_V, L_Q = 65536, L_WS = 131072 + 4096, L_CTRL = 131072 + 4096 + 2048;
#define KSWZ(row, colB) ((row) * 256 + ((colB) ^ (((row) & 7) << 4)))
#define SBAR() __builtin_amdgcn_sched_barrier(0)
DI int v_st(int k, int c) { const int kk = (k & ~0xC) | ((k & 4) << 1) | ((k & 8) >> 1); return ((kk >> 3) * 4 + (c >> 5)) * 512 + ((kk & 7) * 32 + (c & 31)) * 2; }
DI int v_rd_base(int lane) { return ((lane & 3) << 3) | (((lane >> 2) & 3) << 6) | (((lane >> 4) & 1) << 5) | (((lane >> 5) & 1) << 8); }
constexpr int v_rd_off(int d0, int ks, int half) { return d0 * 512 + ks * 4096 + half * 2048; }
DI int crow(int r, int hi) { return (r & 3) + 8 * (r >> 2) + 4 * hi; }

DI void glds16s(const void* sbase, unsigned voff, unsigned lds_dst) {
    unsigned keep;
    asm volatile("s_mov_b32 %0, m0\n\ts_mov_b32 m0, %3\n\ts_nop 0\n\tglobal_load_lds_dwordx4 %1, %2\n\ts_mov_b32 m0, %0" : "=&s"(keep) : "v"(voff), "s"(sbase), "s"(lds_dst) : "memory");
}
template <int NK>
DI void qkt(f32x16& p0, f32x16& p1, LAS const unsigned char* Kb, int r32, int hi, int cofs, const bf16x8* qr, float cinit) {
#pragma unroll
    for (int r = 0; r < 16; ++r) { p0[r] = cinit; p1[r] = cinit; }
    LAS const unsigned char* kb[4];
#pragma unroll
    for (int dd = 0; dd < 4; ++dd) kb[dd] = Kb + KSWZ(r32, (dd * 16 + hi * 8) * 2) + cofs;
#pragma unroll
    for (int d0 = 0; d0 < NK; ++d0) { LAS const unsigned char* a = kb[d0 & 3] + (d0 >> 2) * 128;
        const bf16x8 b0 = *(LAS const bf16x8*)a, b1 = *(LAS const bf16x8*)(a + 32 * 256);
        p0 = __builtin_amdgcn_mfma_f32_32x32x16_bf16(b0, qr[d0], p0, 0, 0, 0);
        p1 = __builtin_amdgcn_mfma_f32_32x32x16_bf16(b1, qr[d0], p1, 0, 0, 0); }
}
DI void qkt_lq(f32x16& p0, f32x16& p1, LAS const unsigned char* Kb, LAS const unsigned char* Qw, int r32, int hi, int cofs) {
    f32x16 z;
#pragma unroll
    for (int r = 0; r < 16; ++r) z[r] = 0.f;
    bf16x8 b0[2], b1[2], q[2];
#define LDF(d0_, sl) do { const int off = KSWZ(r32, ((d0_) * 16 + hi * 8) * 2) + cofs; \
        b0[sl] = *(LAS const bf16x8*)(Kb + off); b1[sl] = *(LAS const bf16x8*)(Kb + off + 32 * 256); q[sl] = *(LAS const bf16x8*)(Qw + off); } while (0)
    LDF(0, 0);
#pragma unroll
    for (int d0 = 0; d0 < 4; ++d0) {
        if (d0 < 3) LDF(d0 + 1, (d0 + 1) & 1);
        if (d0 == 0) { p0 = __builtin_amdgcn_mfma_f32_32x32x16_bf16(b0[0], q[0], z, 0, 0, 0); p1 = __builtin_amdgcn_mfma_f32_32x32x16_bf16(b1[0], q[0], z, 0, 0, 0); }
        else { p0 = __builtin_amdgcn_mfma_f32_32x32x16_bf16(b0[d0 & 1], q[d0 & 1], p0, 0, 0, 0); p1 = __builtin_amdgcn_mfma_f32_32x32x16_bf16(b1[d0 & 1], q[d0 & 1], p1, 0, 0, 0); }
    }
#undef LDF
}
DI void pv_tile(f32x16* o, int vb0, bf16x8 pa0, bf16x8 pa1, bf16x8 pa2, bf16x8 pa3) {
#define TRRD(dst, off) asm volatile("ds_read_b64_tr_b16 %0, %1 offset:%2" : "=&v"(dst) : "v"(vb0), "i"(off) : "memory")
#define PV_D0(d0) do { s16x4 l0, l1, l2, l3, h0, h1, h2, h3; constexpr int b_ = v_rd_off(d0, 0, 0); \
        TRRD(l0, b_); TRRD(h0, b_ + 2048); TRRD(l1, b_ + 4096); TRRD(h1, b_ + 6144); TRRD(l2, b_ + 8192); TRRD(h2, b_ + 10240); TRRD(l3, b_ + 12288); TRRD(h3, b_ + 14336); \
        asm volatile("s_waitcnt lgkmcnt(0)" ::: "memory"); SBAR(); \
        o[d0] = __builtin_amdgcn_mfma_f32_32x32x16_bf16(pa0, (bf16x8){l0[0], l0[1], l0[2], l0[3], h0[0], h0[1], h0[2], h0[3]}, o[d0], 0, 0, 0); \
        o[d0] = __builtin_amdgcn_mfma_f32_32x32x16_bf16(pa1, (bf16x8){l1[0], l1[1], l1[2], l1[3], h1[0], h1[1], h1[2], h1[3]}, o[d0], 0, 0, 0); \
        o[d0] = __builtin_amdgcn_mfma_f32_32x32x16_bf16(pa2, (bf16x8){l2[0], l2[1], l2[2], l2[3], h2[0], h2[1], h2[2], h2[3]}, o[d0], 0, 0, 0); \
        o[d0] = __builtin_amdgcn_mfma_f32_32x32x16_bf16(pa3, (bf16x8){l3[0], l3[1], l3[2], l3[3], h3[0], h3[1], h3[2], h3[3]}, o[d0], 0, 0, 0); } while (0)
    PV_D0(0); PV_D0(1); PV_D0(2); PV_D0(3);
#undef PV_D0
#undef TRRD
}
DI void pv_tile_db(f32x16* o, int vb0, bf16x8 pa0, bf16x8 pa1, bf16x8 pa2, bf16x8 pa3) {
#define TRRD(dst, off) asm volatile("ds_read_b64_tr_b16 %0, %1 offset:%2" : "=&v"(dst) : "v"(vb0), "i"(off) : "memory")
#define VLD(S, d0) do { constexpr int b_ = v_rd_off(d0, 0, 0); TRRD(S##l0, b_); TRRD(S##h0, b_ + 2048); TRRD(S##l1, b_ + 4096); TRRD(S##h1, b_ + 6144); \
        TRRD(S##l2, b_ + 8192); TRRD(S##h2, b_ + 10240); TRRD(S##l3, b_ + 12288); TRRD(S##h3, b_ + 14336); } while (0)
#define LWAIT(n) do { asm volatile("s_waitcnt lgkmcnt(" #n ")" ::: "memory"); SBAR(); } while (0)
#define VF(l, h) (bf16x8){l[0], l[1], l[2], l[3], h[0], h[1], h[2], h[3]}
#define PVX(S, d0) do { \
        o[d0] = __builtin_amdgcn_mfma_f32_32x32x16_bf16(pa0, VF(S##l0, S##h0), o[d0], 0, 0, 0); o[d0] = __builtin_amdgcn_mfma_f32_32x32x16_bf16(pa1, VF(S##l1, S##h1), o[d0], 0, 0, 0); \
        o[d0] = __builtin_amdgcn_mfma_f32_32x32x16_bf16(pa2, VF(S##l2, S##h2), o[d0], 0, 0, 0); o[d0] = __builtin_amdgcn_mfma_f32_32x32x16_bf16(pa3, VF(S##l3, S##h3), o[d0], 0, 0, 0); SBAR(); } while (0)
    s16x4 Al0, Al1, Al2, Al3, Ah0, Ah1, Ah2, Ah3, Bl0, Bl1, Bl2, Bl3, Bh0, Bh1, Bh2, Bh3;
    VLD(A, 0);
    VLD(B, 1); LWAIT(8); PVX(A, 0);
    VLD(A, 2); LWAIT(8); PVX(B, 1);
    VLD(B, 3); LWAIT(8); PVX(A, 2);
    LWAIT(0); PVX(B, 3);
#undef PVX
#undef VF
#undef LWAIT
#undef VLD
#undef TRRD
}
DI void pack_p(const f32x16& p0, const f32x16& p1, bf16x8& pa0, bf16x8& pa1, bf16x8& pa2, bf16x8& pa3) {
#define PK4(P, B_, OUT) do { u32x4 w = {cvt_pk_bf16(P[B_+0], P[B_+1]), cvt_pk_bf16(P[B_+2], P[B_+3]), cvt_pk_bf16(P[B_+4], P[B_+5]), cvt_pk_bf16(P[B_+6], P[B_+7])}; \
        OUT = __builtin_bit_cast(bf16x8, w); } while (0)
    PK4(p0, 0, pa0); PK4(p0, 8, pa1); PK4(p1, 0, pa2); PK4(p1, 8, pa3);
#undef PK4
}
struct Ptrs { const bf16_t *sbQ, *sbK, *sbV, *dfQ, *dfK, *dfV, *G; bf16_t* MIX; const float* subw; float lam, boff; };

DI void pv_tile2(f32x16* o, int vb0, const bf16x8* pa, const bf16x8* pb) {
#define TRRD(dst, off) asm volatile("ds_read_b64_tr_b16 %0, %1 offset:%2" : "=&v"(dst) : "v"(vb0), "i"(off) : "memory")
#define PV_D0(d0) do { s16x4 l0, l1, l2, l3, h0, h1, h2, h3; constexpr int b_ = v_rd_off(d0, 0, 0); \
        TRRD(l0, b_); TRRD(h0, b_ + 2048); TRRD(l1, b_ + 4096); TRRD(h1, b_ + 6144); TRRD(l2, b_ + 8192); TRRD(h2, b_ + 10240); TRRD(l3, b_ + 12288); TRRD(h3, b_ + 14336); \
        asm volatile("s_waitcnt lgkmcnt(0)" ::: "memory"); SBAR(); \
        const bf16x8 v0 = (bf16x8){l0[0], l0[1], l0[2], l0[3], h0[0], h0[1], h0[2], h0[3]}, v1 = (bf16x8){l1[0], l1[1], l1[2], l1[3], h1[0], h1[1], h1[2], h1[3]}; \
        const bf16x8 v2 = (bf16x8){l2[0], l2[1], l2[2], l2[3], h2[0], h2[1], h2[2], h2[3]}, v3 = (bf16x8){l3[0], l3[1], l3[2], l3[3], h3[0], h3[1], h3[2], h3[3]}; \
        o[d0] = __builtin_amdgcn_mfma_f32_32x32x16_bf16(pa[0], v0, o[d0], 0, 0, 0); o[4 + d0] = __builtin_amdgcn_mfma_f32_32x32x16_bf16(pb[0], v0, o[4 + d0], 0, 0, 0); \
        o[d0] = __builtin_amdgcn_mfma_f32_32x32x16_bf16(pa[1], v1, o[d0], 0, 0, 0); o[4 + d0] = __builtin_amdgcn_mfma_f32_32x32x16_bf16(pb[1], v1, o[4 + d0], 0, 0, 0); \
        o[d0] = __builtin_amdgcn_mfma_f32_32x32x16_bf16(pa[2], v2, o[d0], 0, 0, 0); o[4 + d0] = __builtin_amdgcn_mfma_f32_32x32x16_bf16(pb[2], v2, o[4 + d0], 0, 0, 0); \
        o[d0] = __builtin_amdgcn_mfma_f32_32x32x16_bf16(pa[3], v3, o[d0], 0, 0, 0); o[4 + d0] = __builtin_amdgcn_mfma_f32_32x32x16_bf16(pb[3], v3, o[4 + d0], 0, 0, 0); } while (0)
    PV_D0(0); PV_D0(1); PV_D0(2); PV_D0(3);
#undef PV_D0
#undef TRRD
}
template <int DF, int VAR = 0>
DI void attn_unit(const Ptrs& P, int bh, int qb, LAS unsigned char* lds) {
    int tid = threadIdx.x; asm volatile("" : "+v"(tid));
    const int wid = __builtin_amdgcn_readfirstlane(tid >> 6), lane = tid & 63, r32 = lane & 31, hi = lane >> 5;
    constexpr int QROWS = 256, INCL = DF ? 1 : 0, NO = DF ? 8 : 4;
    const int i0 = qb * QROWS;
    const int qlo = i0 + 32 * wid, b = bh >> 3, h = bh & 7;
    const bf16_t* Qh = (DF ? P.dfQ : P.sbQ) + (size_t)bh * SEQ * HD;
    const bf16_t* Kh = (DF ? P.dfK : P.sbK) + (size_t)bh * TPAD * HD;
    const bf16_t* Vh = (DF ? P.dfV : P.sbV) + (size_t)bh * TPAD * HD;
    const int NT = (i0 + QROWS) / 64 + 1;
    LAS unsigned char* V_lds = lds + L_V; LAS unsigned char* K_lds = lds + L_K;
    LAS float* wsf = (LAS float*)(lds + L_WS) + wid * 64;
    LAS unsigned* eflag = (LAS unsigned*)(lds + L_CTRL) + 16;
    bf16x8 qr[8];
    LAS unsigned char* Q_lds = lds + L_Q + wid * 8192;
    if (DF) {
#pragma unroll
        for (int i = 0; i < 8; ++i) { const int p = i * 64 + lane, row = p >> 4, cs = p & 15, c = cs ^ (row & 7);
            glds16s(Qh + (size_t)qlo * HD, (unsigned)(row * HD + c * 8) * 2u, (unsigned)__builtin_amdgcn_readfirstlane((unsigned)(uintptr_t)Q_lds + i * 1024)); }
    } else {
#pragma unroll
        for (int d0 = 0; d0 < 8; ++d0) qr[d0] = *(const bf16x8*)(Qh + (size_t)(qlo + r32) * HD + d0 * 16 + hi * 8);
    }
    const int vbase = (int)(unsigned)(uintptr_t)V_lds + v_rd_base(lane);
    unsigned koff[2], voff[2];
#pragma unroll
    for (int i = 0; i < 2; ++i) { const int p = (i * 8 + wid) * 64 + lane;
        { const int row = p >> 4, cs = p & 15, c = cs ^ (row & 7); koff[i] = (unsigned)(row * HD + c * 8) * 2u; }
        { const int st = p >> 5, kk = (st >> 2) * 8 + ((p & 31) >> 2), k = kk  , c = (st & 3) * 32 + (p & 3) * 8; voff[i] = (unsigned)(k * HD + c) * 2u; } }
    const unsigned ldsK0 = (unsigned)(uintptr_t)K_lds + wid * 1024, ldsV0 = (unsigned)(uintptr_t)V_lds + wid * 1024;
#define DMA(kt_, bf) do { const char* kb_ = (const char*)(Kh + (size_t)(kt_) * 64 * HD); const char* vb_ = (const char*)(Vh + (size_t)(kt_) * 64 * HD); \
        _Pragma("unroll") for (int _i = 0; _i < 2; ++_i) { \
            glds16s(kb_, koff[_i], (unsigned)__builtin_amdgcn_readfirstlane(ldsK0 + (bf) * SHM_K + _i * 8192)); \
            glds16s(vb_, voff[_i], (unsigned)__builtin_amdgcn_readfirstlane(ldsV0 + (bf) * SHM_V + _i * 8192)); } } while (0)
    f32x16 o[NO];
#pragma unroll
    for (int d = 0; d < NO; ++d)
#pragma unroll
        for (int r = 0; r < 16; ++r) o[d][r] = 0.f;
    bool wdone = false;
    float carry = 1.f, lsum0 = 0.f, lsum1 = 0.f;
    DMA(DF ? 0 : NT - 1, 0);
    asm volatile("s_waitcnt vmcnt(0)" ::: "memory");
    if (!DF) {
#pragma unroll
        for (int d0 = 0; d0 < 8; ++d0) asm volatile("" : "+v"(qr[d0]));
    }
    __syncthreads();
    for (int it = 0; it < NT; ++it) {
        const int kt = DF ? it : NT - 1 - it, buf = it & 1;
        if (it + 1 < NT && !(VAR & 2)) DMA(DF ? kt + 1 : kt - 1, buf ^ 1);
        const int j0 = 64 * (kt - 1);
        const bool act = (kt == 0) || (j0 < qlo + 31 + INCL);
        const bool need_mask = (kt == 0) || (j0 + 63 >= qlo + INCL);
        if (act && !(VAR & 4) && !(!DF && SB_EARLY_EXIT && wdone)) {
            const int thi = qlo + r32 - j0 + INCL - 4 * hi;
            if (DF) {
                LAS const unsigned char* Kb = K_lds + buf * SHM_K;
                const int vb0 = vbase + buf * SHM_V;
                f32x16 s0a, s0b, s1a, s1b;
                qkt_lq(s0a, s0b, Kb, Q_lds, r32, hi, 0);
                SBAR();
                {
                    f32x16 z;
#pragma unroll
                    for (int r = 0; r < 16; ++r) z[r] = 0.f;
                    bf16x8 kb0[2], kb1[2], qf[2];
#define LDF(d0_, sl) do { const int off = KSWZ(r32, ((d0_) * 16 + hi * 8) * 2) + 128; \
                        kb0[sl] = *(LAS const bf16x8*)(Kb + off); kb1[sl] = *(LAS const bf16x8*)(Kb + off + 32 * 256); qf[sl] = *(LAS const bf16x8*)(Q_lds + off); } while (0)
                    LDF(0, 0);
#pragma unroll
                    for (int d0 = 0; d0 < 4; ++d0) {
                        if (d0 < 3) LDF(d0 + 1, (d0 + 1) & 1);
                        SBAR();
                        if (d0 == 0) s1a = __builtin_amdgcn_mfma_f32_32x32x16_bf16(kb0[0], qf[0], z, 0, 0, 0); else s1a = __builtin_amdgcn_mfma_f32_32x32x16_bf16(kb0[d0 & 1], qf[d0 & 1], s1a, 0, 0, 0);
#pragma unroll
                        for (int j = 0; j < 4; ++j) if (!(VAR & 32)) s0a[4 * d0 + j] = __builtin_amdgcn_exp2f(s0a[4 * d0 + j]);
                        SBAR();
                        if (d0 == 0) s1b = __builtin_amdgcn_mfma_f32_32x32x16_bf16(kb1[0], qf[0], z, 0, 0, 0); else s1b = __builtin_amdgcn_mfma_f32_32x32x16_bf16(kb1[d0 & 1], qf[d0 & 1], s1b, 0, 0, 0);
#pragma unroll
                        for (int j = 0; j < 4; ++j) if (!(VAR & 32)) s0b[4 * d0 + j] = __builtin_amdgcn_exp2f(s0b[4 * d0 + j]);
                        SBAR();
                    }
#undef LDF
                }
#define DF_MASK(PA, PB) do { if (need_mask) { if (kt == 0) { _Pragma("unroll") for (int r = 0; r < 16; ++r) { PA[r] = 0.f; if (r < 8) PB[r] = 0.f; } } \
                    else { _Pragma("unroll") for (int r = 0; r < 16; ++r) { const int c = (r & 3) + 8 * (r >> 2); if (c >= thi) PA[r] = 0.f; if (c + 32 >= thi) PB[r] = 0.f; } } } } while (0)
                bf16x8 pa[4];
                { DF_MASK(s0a, s0b); float ps = 0.f;
                  { float t_[16];
                    _Pragma("unroll") for (int r = 0; r < 16; ++r) t_[r] = s0a[r] + s0b[r];
                    _Pragma("unroll") for (int w_ = 8; w_ >= 1; w_ >>= 1) { _Pragma("unroll") for (int r = 0; r < w_; ++r) t_[r] += t_[r + w_]; }
                    ps = t_[0]; }
                  asm volatile("" : "+v"(ps)); lsum0 += ps; pack_p(s0a, s0b, pa[0], pa[1], pa[2], pa[3]); }
                SBAR();
#define TRRD(dst, off) asm volatile("ds_read_b64_tr_b16 %0, %1 offset:%2" : "=&v"(dst) : "v"(vb0), "i"(off) : "memory")
#define VFRAG(l, h) (bf16x8){l[0], l[1], l[2], l[3], h[0], h[1], h[2], h[3]}
#define EXP2(X, B_) do { if (!(VAR & 32)) { X[B_] = __builtin_amdgcn_exp2f(X[B_]); X[B_ + 1] = __builtin_amdgcn_exp2f(X[B_ + 1]); } } while (0)
#define VLD(S, d0) do { constexpr int b_ = v_rd_off(d0, 0, 0); TRRD(S##l0, b_); TRRD(S##h0, b_ + 2048); TRRD(S##l1, b_ + 4096); TRRD(S##h1, b_ + 6144); \
        TRRD(S##l2, b_ + 8192); TRRD(S##h2, b_ + 10240); TRRD(S##l3, b_ + 12288); TRRD(S##h3, b_ + 14336); } while (0)
#define LWAIT(n) do { asm volatile("s_waitcnt lgkmcnt(" #n ")" ::: "memory"); SBAR(); } while (0)
#define PVA(S, d0, SX, EB) do { \
        o[d0] = __builtin_amdgcn_mfma_f32_32x32x16_bf16(pa[0], VFRAG(S##l0, S##h0), o[d0], 0, 0, 0); EXP2(SX, EB); SBAR(); \
        o[d0] = __builtin_amdgcn_mfma_f32_32x32x16_bf16(pa[1], VFRAG(S##l1, S##h1), o[d0], 0, 0, 0); EXP2(SX, EB + 2); SBAR(); \
        o[d0] = __builtin_amdgcn_mfma_f32_32x32x16_bf16(pa[2], VFRAG(S##l2, S##h2), o[d0], 0, 0, 0); EXP2(SX, EB + 4); SBAR(); \
        o[d0] = __builtin_amdgcn_mfma_f32_32x32x16_bf16(pa[3], VFRAG(S##l3, S##h3), o[d0], 0, 0, 0); EXP2(SX, EB + 6); SBAR(); } while (0)
#define PVB(S, d0) do { \
        o[4 + d0] = __builtin_amdgcn_mfma_f32_32x32x16_bf16(pb[0], VFRAG(S##l0, S##h0), o[4 + d0], 0, 0, 0); \
        o[4 + d0] = __builtin_amdgcn_mfma_f32_32x32x16_bf16(pb[1], VFRAG(S##l1, S##h1), o[4 + d0], 0, 0, 0); \
        o[4 + d0] = __builtin_amdgcn_mfma_f32_32x32x16_bf16(pb[2], VFRAG(S##l2, S##h2), o[4 + d0], 0, 0, 0); \
        o[4 + d0] = __builtin_amdgcn_mfma_f32_32x32x16_bf16(pb[3], VFRAG(S##l3, S##h3), o[4 + d0], 0, 0, 0); SBAR(); } while (0)
                s16x4 Al0, Al1, Al2, Al3, Ah0, Ah1, Ah2, Ah3, Bl0, Bl1, Bl2, Bl3, Bh0, Bh1, Bh2, Bh3;
                __builtin_amdgcn_s_setprio(1);
                if (!(VAR & 16)) {
                VLD(A, 0);
                VLD(B, 1); LWAIT(8); PVA(A, 0, s1a, 0);
                VLD(A, 2); LWAIT(8); PVA(B, 1, s1a, 8);
                VLD(B, 3); LWAIT(8); PVA(A, 2, s1b, 0);
                VLD(A, 0); LWAIT(8); PVA(B, 3, s1b, 8);
                } else { _Pragma("unroll") for (int r = 0; r < 16; r += 2) { EXP2(s1a, r); EXP2(s1b, r); } if (!(VAR & 8)) VLD(A, 0); }
                bf16x8 pb[4];
                { DF_MASK(s1a, s1b); float ps = 0.f;
                  { float t_[16];
                    _Pragma("unroll") for (int r = 0; r < 16; ++r) t_[r] = s1a[r] + s1b[r];
                    _Pragma("unroll") for (int w_ = 8; w_ >= 1; w_ >>= 1) { _Pragma("unroll") for (int r = 0; r < w_; ++r) t_[r] += t_[r + w_]; }
                    ps = t_[0]; }
                  asm volatile("" : "+v"(ps)); lsum1 += ps; pack_p(s1a, s1b, pb[0], pb[1], pb[2], pb[3]); }
                SBAR();
                if (!(VAR & 8)) {
                VLD(B, 1); LWAIT(8); PVB(A, 0);
                VLD(A, 2); LWAIT(8); PVB(B, 1);
                VLD(B, 3); LWAIT(8); PVB(A, 2);
                LWAIT(0); PVB(B, 3);
                }
                __builtin_amdgcn_s_setprio(0);
#undef VLD
#undef LWAIT
#undef PVA
#undef PVB
#undef PVA_D0
#undef PVB_D0
#undef TRRD
#undef VFRAG
#undef EXP2
#undef DF_MASK
            } else {
                f32x16 p0, p1;
                qkt<8>(p0, p1, K_lds + buf * SHM_K, r32, hi, 0, qr, 0.f);
#pragma unroll
                for (int r = 0; r < 16; ++r) { p0[r] = 1.f - __builtin_amdgcn_rcpf(1.f + __builtin_amdgcn_exp2f(p0[r])); p1[r] = 1.f - __builtin_amdgcn_rcpf(1.f + __builtin_amdgcn_exp2f(p1[r])); }
                if (need_mask) {
                    if (kt == 0) {
#pragma unroll
                        for (int r = 0; r < 16; ++r) { p0[r] = 1.f; if (r < 8) p1[r] = 1.f; }
                    } else {
#pragma unroll
                        for (int r = 0; r < 16; ++r) { const int c = (r & 3) + 8 * (r >> 2);
                            if (c >= thi) p0[r] = 1.f;
                            if (c + 32 >= thi) p1[r] = 1.f; }
                    }
                }
                float Glo[2][4], Ghi[2][4];
#pragma unroll
                for (int g = 0; g < 4; ++g) {
                    const float g0 = (p0[4 * g] * p0[4 * g + 1]) * (p0[4 * g + 2] * p0[4 * g + 3]);
                    const float g1 = (p1[4 * g] * p1[4 * g + 1]) * (p1[4 * g + 2] * p1[4 * g + 3]);
                    auto r0 = __builtin_amdgcn_permlane32_swap(__float_as_uint(g0), __float_as_uint(g0), false, false);
                    auto r1 = __builtin_amdgcn_permlane32_swap(__float_as_uint(g1), __float_as_uint(g1), false, false);
                    Glo[0][g] = __uint_as_float(r0[0]); Ghi[0][g] = __uint_as_float(r0[1]); Glo[1][g] = __uint_as_float(r1[0]); Ghi[1][g] = __uint_as_float(r1[1]);
                }
                float run = carry;
#pragma unroll
                for (int x = 1; x >= 0; --x)
#pragma unroll
                    for (int g = 3; g >= 0; --g) {
                        const float e1 = run; run *= Ghi[x][g]; const float e0 = run; run *= Glo[x][g];
                        float e = hi ? e1 : e0;
#pragma unroll
                        for (int j = 3; j >= 0; --j) {
                            if (x == 0) { const float en = p0[4 * g + j] * e; p0[4 * g + j] = e - en; e = en; }
                            else        { const float en = p1[4 * g + j] * e; p1[4 * g + j] = e - en; e = en; }
                        }
                    }
                carry = run;
                bf16x8 pa0, pa1, pa2, pa3;
                pack_p(p0, p1, pa0, pa1, pa2, pa3);
                __builtin_amdgcn_s_setprio(1);
                pv_tile_db(o, vbase + buf * SHM_V, pa0, pa1, pa2, pa3);
                __builtin_amdgcn_s_setprio(0);
            }
        }
        if (!DF && SB_EARLY_EXIT) { wdone = __all(carry == 0.f); if (lane == 0) eflag[(it & 1) * 8 + wid] = wdone ? 1u : 0u; }
        asm volatile("s_waitcnt vmcnt(0)" ::: "memory");
        __syncthreads();
        if (!DF && SB_EARLY_EXIT) { const u32x4 f0 = *(LAS const u32x4*)(eflag + (it & 1) * 8), f1 = *(LAS const u32x4*)(eflag + (it & 1) * 8 + 4);
            if (((f0.x & f0.y) & (f0.z & f0.w)) & ((f1.x & f1.y) & (f1.z & f1.w))) break; }
    }
#undef DMA
    int lane_e = lane; asm volatile("" : "+v"(lane_e));
    constexpr int SPITCH = 272;
    LAS unsigned char* stg = lds + wid * 8704;
    if (DF) {
        { auto rr = __builtin_amdgcn_permlane32_swap(__float_as_uint(lsum0), __float_as_uint(lsum0), false, false); lsum0 = __uint_as_float(rr[0]) + __uint_as_float(rr[1]); }
        { auto rr = __builtin_amdgcn_permlane32_swap(__float_as_uint(lsum1), __float_as_uint(lsum1), false, false); lsum1 = __uint_as_float(rr[0]) + __uint_as_float(rr[1]); }
        wsf[lane] = hi ? lsum1 : lsum0;
        asm volatile("s_waitcnt lgkmcnt(0)" ::: "memory");
        const float lam = P.lam;
        float ss[16];
#pragma unroll
        for (int r = 0; r < 16; ++r) { const float rl0 = __builtin_amdgcn_rcpf(wsf[crow(r, hi)]), rl1 = lam * __builtin_amdgcn_rcpf(wsf[32 + crow(r, hi)]); float q = 0.f;
#pragma unroll
            for (int d = 0; d < 4; ++d) { const float v = o[d][r] * rl0 - o[NO - 4 + d][r] * rl1; o[d][r] = v; q += v * v; }
            ss[r] = q; }
#pragma unroll
        for (int r = 0; r < 16; ++r) {
            ss[r] += __int_as_float(__builtin_amdgcn_update_dpp(0, __float_as_int(ss[r]), 0xB1, 0xF, 0xF, true));
            ss[r] += __int_as_float(__builtin_amdgcn_update_dpp(0, __float_as_int(ss[r]), 0x4E, 0xF, 0xF, true));
            ss[r] += __int_as_float(__builtin_amdgcn_update_dpp(0, __float_as_int(ss[r]), 0x141, 0xF, 0xF, true));
            ss[r] += __int_as_float(__builtin_amdgcn_update_dpp(0, __float_as_int(ss[r]), 0x140, 0xF, 0xF, true));
            ss[r] += __shfl_xor(ss[r], 16);
            ss[r] = __builtin_amdgcn_rsqf(ss[r] * (1.f / 128.f) + SUBLN_EPS) * (1.f - LAM_INIT);
        }
#pragma unroll
        for (int d = 0; d < 4; ++d) { const float w = P.subw[d * 32 + r32];
#pragma unroll
            for (int r = 0; r < 16; ++r) o[d][r] = o[d][r] * ss[r] * w; }
    }
    {
#pragma unroll
        for (int d = 0; d < 4; ++d)
#pragma unroll
            for (int r = 0; r < 16; ++r) { const float v = o[d][r]; const float vn = __int_as_float(__builtin_amdgcn_update_dpp(0, __float_as_int(v), 0xB1, 0xF, 0xF, true));
                if ((r32 & 1) == 0) *(LAS unsigned*)(stg + crow(r, hi) * SPITCH + (d * 32 + r32) * 2) = cvt_pk_bf16(v, vn); }
        asm volatile("s_waitcnt lgkmcnt(0)" ::: "memory");
        const size_t grow0 = (size_t)(b * SEQ + qlo); const int gcol0 = (DF ? 1024 : 0) + h * HD;
        u32x4 gv[8];
#pragma unroll
        for (int it = 0; it < 8; ++it) { const int c = it * 64 + lane_e, row = c >> 4, ch = c & 15; gv[it] = *(const u32x4*)(P.G + (grow0 + row) * DM + gcol0 + ch * 8); }
#pragma unroll
        for (int it = 0; it < 8; ++it) { const int c = it * 64 + lane_e, row = c >> 4, ch = c & 15;
            const u32x4 ov = *(LAS const u32x4*)(stg + row * SPITCH + ch * 16);
            const size_t goff = (grow0 + row) * DM + gcol0 + ch * 8;
            u32x4 w;
            w.x = cvt_pk_bf16(bf_lo(ov.x) * bf_lo(gv[it].x), bf_hi(ov.x) * bf_hi(gv[it].x)); w.y = cvt_pk_bf16(bf_lo(ov.y) * bf_lo(gv[it].y), bf_hi(ov.y) * bf_hi(gv[it].y));
            w.z = cvt_pk_bf16(bf_lo(ov.z) * bf_lo(gv[it].z), bf_hi(ov.z) * bf_hi(gv[it].z)); w.w = cvt_pk_bf16(bf_lo(ov.w) * bf_lo(gv[it].w), bf_hi(ov.w) * bf_hi(gv[it].w));
            if (!(VAR & 1)) *(u32x4*)(P.MIX + goff) = w; }
    }
}

#undef KSWZ
#undef SBAR
}

#define XB_TMO      128
#define XB_XCNT(j)  (256  + 64 * (j))
#define XB_XSUB(j)  (1280 + 64 * (j))
#define XB_XGEN(j)  (2304 + 64 * (j))
#define XB_TOP      3328
#define XB_TOPGEN   3392
#define XCD_BAR_WORDS 3456
#define XB_SPIN_CAP (1u << 18)
DI unsigned xb_ld(unsigned* p)              { return __hip_atomic_load(p, __ATOMIC_RELAXED, __HIP_MEMORY_SCOPE_AGENT); }
DI unsigned xb_add(unsigned* p, unsigned v) { return __hip_atomic_fetch_add(p, v, __ATOMIC_RELAXED, __HIP_MEMORY_SCOPE_AGENT); }
DI unsigned xb_xcc_id() { return (unsigned)__builtin_amdgcn_s_getreg((3 << 11) | 20) & 0xFu; }
#define XB_SPIN(cond, bar) do { unsigned _sp = 0; while (cond) { __builtin_amdgcn_s_sleep(1); \
    if ((++_sp & 255u) == 0u) { if (xb_ld(&(bar)[XB_TMO])) break; if (_sp > XB_SPIN_CAP) { atomicAdd(&(bar)[XB_TMO], 1u); break; } } } } while (0)
struct XcdBarrier { unsigned* bar; unsigned x; volatile LAS unsigned* st; };
DI XcdBarrier xcd_barrier_post(unsigned* bar, volatile LAS unsigned* st) {
    XcdBarrier b; b.bar = bar; b.x = xb_xcc_id(); b.st = st;
    if (threadIdx.x == 0) (void)xb_add(&bar[XB_XCNT(b.x)], 1u);
    return b;
}
DI void xcd_barrier_complete(unsigned* bar, unsigned x, unsigned& nloc, unsigned& nx) {
    const unsigned G = gridDim.x * gridDim.y * gridDim.z;
    unsigned sum, cnt, mine, sp = 0u;
    for (;;) {
        sum = 0u; cnt = 0u; mine = 0u;
#pragma unroll
        for (unsigned j = 0; j < 16; ++j) { const unsigned c = xb_ld(&bar[XB_XCNT(j)]); sum += c; cnt += (c > 0u) ? 1u : 0u; mine = (j == x) ? c : mine; }
        if (sum == G) break;
        __builtin_amdgcn_s_sleep(1);
        if ((++sp & 255u) == 0u) { if (xb_ld(&bar[XB_TMO])) break; if (sp > XB_SPIN_CAP) { atomicAdd(&bar[XB_TMO], 1u); break; } }
    }
    nloc = mine > 0u ? mine : 1u; nx = cnt > 0u ? cnt : 1u;
}
DI void xcd_barrier(const XcdBarrier& b) {
    asm volatile("s_waitcnt vmcnt(0)" ::: "memory");
    __syncthreads();
    if (threadIdx.x == 0) {
        unsigned* bar = b.bar;
        __builtin_amdgcn_s_waitcnt(0);
        unsigned nloc = b.st[0], nx = b.st[1];
        if (nloc == 0u) { xcd_barrier_complete(bar, b.x, nloc, nx); b.st[0] = nloc; b.st[1] = nx; }
        const unsigned old = xb_add(&bar[XB_XSUB(b.x)], 1u);
        const unsigned gen = old / nloc;
        if (old + 1u == (gen + 1u) * nloc) {
            __builtin_amdgcn_fence(__ATOMIC_RELEASE, "agent");
            asm volatile("s_waitcnt vmcnt(0)" ::: "memory");
            const unsigned og = xb_add(&bar[XB_TOP], 1u);
            const unsigned tg = og / nx;
            if (og + 1u == (tg + 1u) * nx) xb_add(&bar[XB_TOPGEN], 1u);
            else XB_SPIN(xb_ld(&bar[XB_TOPGEN]) == tg, bar);
            __builtin_amdgcn_fence(__ATOMIC_ACQUIRE, "agent");
            xb_add(&bar[XB_XGEN(b.x)], 1u);
            asm volatile("s_waitcnt vmcnt(0)" ::: "memory");
        } else {
            XB_SPIN(xb_ld(&bar[XB_XGEN(b.x)]) == gen, bar);
            __builtin_amdgcn_fence(__ATOMIC_ACQUIRE, "agent");
            asm volatile("s_waitcnt vmcnt(0)" ::: "memory");
        }
    }
    __syncthreads();
}

DI void p0_transpose_item(const float* W, int K, int N, bf16_t* WT, LAS float* scr, int item, int lane) {
    const int nblk = N / 32, kb = item / nblk, nb = item % nblk, k0 = 64 * kb, n0 = 32 * nb;
#pragma unroll 8
    for (int i = 0; i < 32; ++i) { const int kk = 2 * i + (lane >> 5); scr[kk * 33 + (lane & 31)] = W[(size_t)(k0 + kk) * N + n0 + (lane & 31)]; }
    asm volatile("s_waitcnt lgkmcnt(0)" ::: "memory");
    const int c = lane & 7;
#pragma unroll
    for (int j = 0; j < 4; ++j) { const int n = (lane >> 3) + 8 * j; const LAS float* s = scr + (8 * c) * 33 + n;
        u32x4 o; o.x = cvt_pk_bf16(s[0 * 33], s[1 * 33]); o.y = cvt_pk_bf16(s[2 * 33], s[3 * 33]); o.z = cvt_pk_bf16(s[4 * 33], s[5 * 33]); o.w = cvt_pk_bf16(s[6 * 33], s[7 * 33]);
        *(u32x4*)(WT + (size_t)(n0 + n) * K + k0 + 8 * c) = o; }
    asm volatile("s_waitcnt lgkmcnt(0)" ::: "memory");
}
DI void sincos_d(double a, double& s, double& c) {
    const double k = __builtin_rint(a * 0.63661977236758134308);
    const double y = (a - k * 1.57079632679489655800) - k * 6.123233995736766e-17;
    const double y2 = y * y;
    double sp = -1.0 / 1307674368000.0; sp = sp * y2 + 1.0 / 6227020800.0; sp = sp * y2 - 1.0 / 39916800.0; sp = sp * y2 + 1.0 / 362880.0; sp = sp * y2 - 1.0 / 5040.0; sp = sp * y2 + 1.0 / 120.0; sp = sp * y2 - 1.0 / 6.0; sp = sp * y2 + 1.0;
    const double sy = sp * y;
    double cp = 1.0 / 20922789888000.0; cp = cp * y2 - 1.0 / 87178291200.0; cp = cp * y2 + 1.0 / 479001600.0; cp = cp * y2 - 1.0 / 3628800.0; cp = cp * y2 + 1.0 / 40320.0; cp = cp * y2 - 1.0 / 720.0; cp = cp * y2 + 1.0 / 24.0; cp = cp * y2 - 0.5; cp = cp * y2 + 1.0;
    const int q = ((int)k) & 3;
    s = (q == 0) ? sy : (q == 1) ? cp : (q == 2) ? -sy : -cp;
    c = (q == 0) ? cp : (q == 1) ? -sy : (q == 2) ? -cp : sy;
}
DI int meta_col(int c64) { const int grp = c64 >> 4, c = c64 & 15; const int base = (grp == 0) ? 1024 : (grp == 1) ? 2048 : (grp == 2) ? 5120 : 6144; return base + c * 64; }

struct Args { const float* in[12]; float* out; unsigned char* ws; int ph_lo, ph_hi, coop, pad; };

__global__ void __launch_bounds__(512, 2) hybrid_fwd(Args args) {
    extern __shared__ __attribute__((aligned(16))) unsigned char lds_raw[];
    LAS unsigned char* lds = (LAS unsigned char*)lds_raw;
    const int tid = threadIdx.x, lane = tid & 63, wave = __builtin_amdgcn_readfirstlane(tid >> 6);
    const int G = gridDim.x, bx = blockIdx.x;
    const int gw = bx * 8 + wave, NGW = G * 8;
    unsigned char* ws = args.ws;
    const float* x = args.in[0]; const float* meta = args.in[1]; const float* norm_w = args.in[2]; const float* w_in = args.in[3];
    const float* qnw = args.in[4]; const float* knw = args.in[5]; const float* lq1 = args.in[6]; const float* lk1 = args.in[7];
    const float* lq2 = args.in[8]; const float* lk2 = args.in[9]; const float* subw = args.in[10]; const float* w_out = args.in[11];
    float* ctlf = (float*)(ws + WS_CTL); unsigned* ctlu = (unsigned*)(ws + WS_CTL);
    float* rope = (float*)(ws + WS_ROPE); float* mpart = (float*)(ws + WS_MPART);
    bf16_t* WinT = (bf16_t*)(ws + WS_WIN); bf16_t* WoutT = (bf16_t*)(ws + WS_WOUT); bf16_t* XN = (bf16_t*)(ws + WS_XN);
    bf16_t* Gt = (bf16_t*)(ws + WS_G); bf16_t* MIX = (bf16_t*)(ws + WS_MIX);
    bf16_t* sbQ = (bf16_t*)(ws + WS_SBQ); bf16_t* sbK = (bf16_t*)(ws + WS_SBK); bf16_t* sbV = (bf16_t*)(ws + WS_SBV);
    bf16_t* dfQ = (bf16_t*)(ws + WS_DFQ); bf16_t* dfK = (bf16_t*)(ws + WS_DFK); bf16_t* dfV = (bf16_t*)(ws + WS_DFV);
    const int lo = args.ph_lo, hi_ph = args.ph_hi;
#define IN(k) (lo <= (k) && (k) < hi_ph)
    { volatile LAS unsigned* st0 = (volatile LAS unsigned*)(lds + 138240); if (tid < 2) st0[tid] = 0u; }
    __syncthreads();
    const XcdBarrier xbar = xcd_barrier_post((unsigned*)(ws + WS_CTL) + 4096, (volatile LAS unsigned*)(lds + 138240));
#define SEAM(k) do { if (IN(k) && IN((k) + 1)) { if (args.coop == 2) cg::this_grid().sync(); else xcd_barrier(xbar); } } while (0)

    if (IN(0)) {
      for (int rep0 = 0; rep0 < REPS(0); ++rep0) {
        LAS float* scr = (LAS float*)(lds + wave * 16384);
        constexpr int I_IN = (DM / 64) * (INW / 32), I_OUT = (DM / 64) * (DM / 32);
        const int gw4 = bx * 4 + (wave & 3), NGW4 = G * 4;
        if (wave < 4) {
        for (int it = gw4; it < I_IN + I_OUT; it += NGW4) {
            if (it < I_IN) p0_transpose_item(w_in, DM, INW, WinT, scr, it, lane);
            else p0_transpose_item(w_out, DM, DM, WoutT, scr, it - I_IN, lane);
        }
        }
        {
            f32x4 nw[8];
#pragma unroll
            for (int j = 0; j < 8; ++j) nw[j] = ((const f32x4*)norm_w)[64 * j + lane];
            if (wave >= 4)
            for (int m = gw4; m < MROWS; m += 2 * NGW4) {
                const int m2 = m + NGW4;
                const bool has2 = m2 < MROWS;
                const f32x4* xr = (const f32x4*)(x + (size_t)m * DM) + lane;
                const f32x4* xr2 = (const f32x4*)(x + (size_t)(has2 ? m2 : m) * DM) + lane;
                f32x4 v[8], u[8]; float s = 0.f, s2 = 0.f;
#pragma unroll
                for (int j = 0; j < 8; ++j) { v[j] = __builtin_nontemporal_load(xr + 64 * j); u[j] = __builtin_nontemporal_load(xr2 + 64 * j); }
#pragma unroll
                for (int j = 0; j < 8; ++j) { s += (v[j].x * v[j].x + v[j].y * v[j].y) + (v[j].z * v[j].z + v[j].w * v[j].w); s2 += (u[j].x * u[j].x + u[j].y * u[j].y) + (u[j].z * u[j].z + u[j].w * u[j].w); }
                const float rstd = __builtin_amdgcn_rsqf(wave_sum(s) * (1.f / DM) + RMS_EPS), rstd2 = __builtin_amdgcn_rsqf(wave_sum(s2) * (1.f / DM) + RMS_EPS);
                u32x2* o8 = (u32x2*)(XN + (size_t)m * DM) + lane;
#pragma unroll
                for (int j = 0; j < 8; ++j) { const f32x4 y = v[j] * rstd * nw[j]; u32x2 w; w.x = cvt_pk_bf16(y.x, y.y); w.y = cvt_pk_bf16(y.z, y.w); o8[64 * j] = w; }
                if (has2) { u32x2* o82 = (u32x2*)(XN + (size_t)m2 * DM) + lane;
#pragma unroll
                    for (int j = 0; j < 8; ++j) { const f32x4 y = u[j] * rstd2 * nw[j]; u32x2 w; w.x = cvt_pk_bf16(y.x, y.y); w.y = cvt_pk_bf16(y.z, y.w); o82[64 * j] = w; } }
            }
        }
        for (int it = gw; it < 64 * 32; it += NGW) {
            const int c64 = it & 63, kc = it >> 6, col = meta_col(c64) + lane, k0 = kc * 64;
            float ml[16];
            const float nwl = norm_w[k0 + lane];
#pragma unroll
            for (int r = 0; r < 16; ++r) ml[r] = meta[(size_t)r * DM + k0 + lane] * nwl;
            float acc[16];
#pragma unroll
            for (int r = 0; r < 16; ++r) acc[r] = 0.f;
            for (int kk = 0; kk < 64; ++kk) {
                const float w = w_in[(size_t)(k0 + kk) * INW + col];
#pragma unroll
                for (int r = 0; r < 16; ++r) acc[r] += __int_as_float(__builtin_amdgcn_readlane(__float_as_int(ml[r]), kk)) * w;
            }
#pragma unroll
            for (int r = 0; r < 16; ++r) mpart[(size_t)(kc * 16 + r) * 4096 + c64 * 64 + lane] = acc[r];
        }
        for (int idx = bx * 512 + tid; idx < (NMETA + SEQ) * 8; idx += G * 512) {
            const int pos = idx >> 3, f = idx & 7;
            const float invf = (f == 0) ? 1.0f : (f == 1) ? 0.1939227432012558f : (f == 2) ? 0.03760603070259094f : (f == 3) ? 0.007292664609849453f :
                               (f == 4) ? 0.0014142135623842478f : (f == 5) ? 0.00027424818836152554f : (f == 6) ? 5.318296098266728e-05f : 1.0313386155758053e-05f;
            const float ang = (float)pos * invf;
            double s, c; sincos_d((double)ang, s, c);
            rope[pos * 16 + f] = (float)c; rope[pos * 16 + 8 + f] = (float)s;
        }
        for (int idx = bx * 512 + tid; idx < 4 * NBH * 48 * 16; idx += G * 512) {
            const int arr = idx / (NBH * 48 * 16), r = idx % (NBH * 48 * 16), bhh = r / (48 * 16), ch = r % (48 * 16);
            size_t aoff = WS_SBK; if (arr == 1) aoff = WS_SBV; if (arr == 2) aoff = WS_DFK; if (arr == 3) aoff = WS_DFV;
            bf16_t* base = (bf16_t*)(ws + aoff);
            *(u32x4*)(base + (size_t)bhh * TPAD * HD + ch * 8) = (u32x4){0u, 0u, 0u, 0u};
        }
        if (bx == 0 && wave == 0) {
            const float s1 = wave_sum(lq1[lane] * lk1[lane]), s2 = wave_sum(lq2[lane] * lk2[lane]);
            const float mq = wave_max(fabsf(qnw[lane])), mk = wave_max(fabsf(knw[lane]));
            if (lane == 0) { ctlf[CW_LAM] = __expf(s1) - __expf(s2) + LAM_INIT; ctlf[CW_BOFF] = 8.f * mq * mk * LOG2E * 1.02f; }
            if (lane < 8) ctlu[CW_QUEUE + 64 * lane] = 0u;
        }
        if (rep0 + 1 < REPS(0)) __syncthreads();
      }
    }
    SEAM(0);
    if (PROBE_PHASE == 7) { for (int i = 0; i < 10; ++i) cg::this_grid().sync(); }

    if (IN(1)) {
        for (int it = gw; it < 64 * 16; it += NGW) {
            const int c64 = it & 63, r = it >> 6;
            float v = 0.f;
            for (int kc = 0; kc < 32; ++kc) v += mpart[(size_t)(kc * 16 + r) * 4096 + c64 * 64 + lane];
            float s = 0.f;
            for (int j = 0; j < 32; ++j) { const float mv = meta[(size_t)r * DM + j * 64 + lane]; s += mv * mv; }
            v *= __builtin_amdgcn_rsqf(wave_sum(s) * (1.f / DM) + RMS_EPS);
            const int grp = c64 >> 4, c = c64 & 15;
            if (grp == 2) {
                const float ss = wave_sum(v * v);
                v = v * __builtin_amdgcn_rsqf(ss * (1.f / 64.f) + RMS_EPS) * knw[lane];
                const float pr = __shfl_xor(v, 8);
                if (lane < 16) { const float cs = rope[r * 16 + (lane & 7)], sn = rope[r * 16 + 8 + (lane & 7)]; v = (lane < 8) ? v * cs - pr * sn : v * cs + pr * sn; }
            }
            size_t aoff = WS_SBK; if (grp == 1) aoff = WS_SBV; if (grp == 2) aoff = WS_DFK; if (grp == 3) aoff = WS_DFV;
            bf16_t* arr = (bf16_t*)(ws + aoff);
            const bf16_t hv = (bf16_t)(cvt_pk_bf16(v, v) & 0xffffu);
            for (int bb = 0; bb < BATCH; ++bb) arr[((size_t)(bb * NH + (c >> 1)) * TPAD + 48 + r) * HD + (c & 1) * 64 + lane] = hv;
        }
        pg8::Gemm g{XN, WinT, MROWS, INW, DM}; pg8::StaticOrder S; S.init(MROWS, INW, G, bx);
        EpiIn E{ws, qnw, knw, rope};
        pg8::gemm_phase<EpiIn, pg8::StaticOrder>(lds, g, S, E);
        if constexpr (PROBE_PHASE == 1) { cg::this_grid().sync(); pg8::gemm_phase<EpiIn, pg8::StaticOrder>(lds, g, S, E); }
    }
    SEAM(1);

    if (IN(2)) {
        att::Ptrs P{sbQ, sbK, sbV, dfQ, dfK, dfV, Gt, MIX, subw, ctlf[CW_LAM], ctlf[CW_BOFF]};
        LAS unsigned* ctrl = (LAS unsigned*)(lds + att::L_CTRL);
        const unsigned xcc = (unsigned)__builtin_amdgcn_s_getreg((3 << 11) | 20) & 7u;
        for (int rep = 0; rep < REPS(2); ++rep) {
        unsigned q = xcc, nxt = 0xffffffffu; int slot = 0;
#define QPOP(qstart) do { unsigned qq = (qstart), L_ = 256u; \
            for (int t = 0; t < 8; ++t) { L_ = atomicAdd(ctlu + CW_QUEUE + 64 * qq, 1u); if (L_ < 256u) break; qq = (qq + 1) & 7u; } \
            nxt = (L_ < 256u) ? ((qq << 8) | L_) : 0xffffffffu; } while (0)
        if (tid == 0) QPOP(q);
        for (;;) {
            if (tid == 0) ctrl[slot] = nxt;
            __syncthreads();
            const unsigned v = (unsigned)__builtin_amdgcn_readfirstlane((int)ctrl[slot]);
            slot ^= 1;
            if (v == 0xffffffffu) break;
            q = v >> 8; const int L = (int)(v & 255u), w = L & 127, pr = w >> 5, wi = w & 31, qb = 15 - (wi >> 1), bh = (int)q * 8 + 2 * pr + (wi & 1);
            if (tid == 0) QPOP(q);
            if (L < 128) att::attn_unit<1>(P, bh, qb, lds);
            else att::attn_unit<0>(P, bh, qb, lds);
        }
#undef QPOP
        if (rep + 1 < REPS(2)) { cg::this_grid().sync(); if (bx == 0 && tid < 8) ctlu[CW_QUEUE + 64 * tid] = 0u; __threadfence(); cg::this_grid().sync(); }
        }
    }
    SEAM(2);

    if (IN(3)) {
        pg8::Gemm g{MIX, WoutT, MROWS, DM, DM}; pg8::StaticOrder S; S.init(MROWS, DM, G, bx);
        EpiOut E{x, args.out};
        pg8::gemm_phase<EpiOut, pg8::StaticOrder>(lds, g, S, E);
        if constexpr (PROBE_PHASE == 3) { cg::this_grid().sync(); pg8::gemm_phase<EpiOut, pg8::StaticOrder>(lds, g, S, E); }
    }
#undef IN
#undef SEAM
}

extern "C" void kernel_launch(void* const* d_in, const int* in_sizes, int n_in, void* d_out, int out_size, void* d_ws, size_t ws_size, hipStream_t stream) {
    static int grid = 0;
    if (grid == 0) {
        if (n_in != 12 || in_sizes[0] != MROWS * DM || out_size != MROWS * DM || ws_size < WS_END) { fprintf(stderr, "kernel_launch: unexpected shapes (n_in %d, ws %zu)\n", n_in, ws_size); grid = -1; return; }
        int dev = 0, cus = 0, per_cu = 0;
        (void)hipGetDevice(&dev); (void)hipDeviceGetAttribute(&cus, hipDeviceAttributeMultiprocessorCount, dev);
        if (hipFuncSetAttribute((const void*)hybrid_fwd, hipFuncAttributeMaxDynamicSharedMemorySize, LDS_BYTES) != hipSuccess) { fprintf(stderr, "kernel_launch: hipFuncSetAttribute failed\n"); grid = -1; return; }
        if (hipOccupancyMaxActiveBlocksPerMultiprocessor(&per_cu, (const void*)hybrid_fwd, 512, LDS_BYTES) != hipSuccess || per_cu < 1) per_cu = 1;
        (void)hipGetLastError();
        grid = cus > 0 ? cus * per_cu : 256;
    }
    if (grid < 0) return;
    if (hipMemsetAsync((char*)d_ws + WS_CTL, 0, 65536, stream) != hipSuccess) { fprintf(stderr, "kernel_launch: hipMemsetAsync failed\n"); return; }
    Args a{};
    for (int i = 0; i < 12; ++i) a.in[i] = (const float*)d_in[i];
    a.out = (float*)d_out; a.ws = (unsigned char*)d_ws; a.ph_lo = 0; a.ph_hi = 4; a.coop = 1; a.pad = 0;
    void* kargs[] = {&a};
    hipError_t e = hipLaunchCooperativeKernel((const void*)hybrid_fwd, dim3(grid), dim3(512), kargs, LDS_BYTES, stream);
    if (e != hipSuccess) fprintf(stderr, "kernel_launch: cooperative launch failed: %s (grid %d)\n", hipGetErrorString(e), grid);
}
```

```cpp
#include <hip/hip_runtime.h>
#include <hip/hip_cooperative_groups.h>
#include <cstdio>
#include <cstdint>
namespace cg = cooperative_groups;

#define LAS __attribute__((address_space(3)))
#define DI __device__ __forceinline__
typedef unsigned short bf16_t;
typedef short bf16x8 __attribute__((ext_vector_type(8)));
typedef short s16x4 __attribute__((ext_vector_type(4)));
typedef float f32x4 __attribute__((ext_vector_type(4)));
typedef float f32x16 __attribute__((ext_vector_type(16)));
typedef unsigned u32x4 __attribute__((ext_vector_type(4)));
typedef unsigned u32x2 __attribute__((ext_vector_type(2)));

constexpr int BATCH = 8, SEQ = 4096, DM = 2048, NMETA = 16, INW = 8192;
constexpr int MROWS = BATCH * SEQ;
constexpr int TPAD = SEQ + 64;
constexpr int NH = 8, HD = 128, NBH = BATCH * NH;
constexpr float RMS_EPS = 1e-6f, SUBLN_EPS = 1e-5f, LAM_INIT = 0.2f;
constexpr float LOG2E = 1.4426950408889634f;
constexpr bool SB_EARLY_EXIT = true;
#ifndef PROBE_PHASE
#define PROBE_PHASE (-1)
#endif
#ifndef PROBE_VAR
#define PROBE_VAR 1
#endif
#ifndef PROBE_REPS
#define PROBE_REPS 2
#endif
#define REPS(k) ((PROBE_PHASE == (k)) ? PROBE_REPS : 1)

constexpr size_t MiB = 1u << 20;
constexpr size_t WS_CTL = 0, WS_ROPE = 1 * MiB, WS_MPART = 2 * MiB, WS_WIN = 16 * MiB, WS_WOUT = 48 * MiB, WS_XN = 64 * MiB,
                 WS_G = 192 * MiB, WS_MIX = 320 * MiB, WS_SBQ = 448 * MiB, WS_SBK = 512 * MiB, WS_SBV = 578 * MiB,
                 WS_DFQ = 644 * MiB, WS_DFK = 708 * MiB, WS_DFV = 774 * MiB, WS_END = 840 * MiB;
constexpr int CW_LAM = 0, CW_BOFF = 1, CW_QUEUE = 64;

constexpr int LDS_BYTES = 147456;

DI unsigned cvt_pk_bf16(float lo, float hi) { unsigned r; asm volatile("v_cvt_pk_bf16_f32 %0, %1, %2" : "=v"(r) : "v"(lo), "v"(hi)); return r; }
DI float bf_lo(unsigned w) { return __uint_as_float(w << 16); }
DI float bf_hi(unsigned w) { return __uint_as_float(w & 0xffff0000u); }
DI float wave_sum(float v) {
    v += __int_as_float(__builtin_amdgcn_update_dpp(0, __float_as_int(v), 0xB1, 0xF, 0xF, true));
    v += __int_as_float(__builtin_amdgcn_update_dpp(0, __float_as_int(v), 0x4E, 0xF, 0xF, true));
    v += __int_as_float(__builtin_amdgcn_update_dpp(0, __float_as_int(v), 0x141, 0xF, 0xF, true));
    v += __int_as_float(__builtin_amdgcn_update_dpp(0, __float_as_int(v), 0x140, 0xF, 0xF, true));
    v += __shfl_xor(v, 16);
    { auto rr = __builtin_amdgcn_permlane32_swap(__float_as_uint(v), __float_as_uint(v), false, false); v = __uint_as_float(rr[0]) + __uint_as_float(rr[1]); }
    return v;
}
DI float wave_max(float v) {
#pragma unroll
    for (int o = 1; o < 64; o <<= 1) v = fmaxf(v, __shfl_xor(v, o));
    return v;
}
DI float silu_f(float g) { return g * __builtin_amdgcn_rcpf(1.f + __builtin_amdgcn_exp2f(-g * LOG2E)); }

namespace pg8 {
constexpr int BM = 256, BK = 64, HALF = 128, HTB = HALF * BK * 2, STAGE_BYTES = 8 * HTB, NXCD = 8, WGM = 8;
__host__ __device__ __forceinline__ int lds_byte(int r, int c) { const int st = (r >> 4) * 2 + (c >> 5), rr = r & 15, cc = c & 31, ob = rr * 64 + cc * 2; return st * 1024 + (ob ^ (((ob >> 9) & 1) << 5)); }
__host__ __device__ __forceinline__ void stage_rc(int b, int& R, int& C) { const int st = b / 1024, sb = b % 1024, swz = sb ^ (((sb >> 9) & 1) << 5); R = (st >> 1) * 16 + swz / 64; C = (st & 1) * 32 + (swz % 64) / 2; }
__host__ __device__ __forceinline__ int perm32(int rho) { const int n = rho >> 4, i = rho & 15; return 8 * (i >> 2) + 4 * n + (i & 3); }
struct Unit { int pm, pn; };
struct Gemm { const bf16_t* A; const bf16_t* Bt; int M, N, K; };
struct StaticOrder {
    int nM, nN, nwg, G, c;
    __device__ void init(int M, int N, int G_, int c_) { nM = M / BM; nN = N / BM; nwg = nM * nN; G = G_; c = c_; }
    __device__ bool next(int i, Unit& u) const {
        const long L = (long)i * G + c; if (L >= nwg) return false;
        int wgid = (int)L; { const int q = nwg / NXCD, r = nwg % NXCD, xcd = wgid % NXCD, off = wgid / NXCD; wgid = (xcd < r ? xcd * (q + 1) : r * (q + 1) + (xcd - r) * q) + off; }
        const int nig = WGM * nN, gid = wgid / nig, fm = gid * WGM, gsz = (nM - fm) < WGM ? (nM - fm) : WGM;
        u.pm = fm + ((wgid % nig) % gsz); u.pn = (wgid % nig) / gsz; return true;
    }
};
template <class Epi, class Sched>
__device__ __forceinline__ void gemm_phase(LAS unsigned char* lds, const Gemm g, const Sched& S, const Epi& E) {
    const int tid = threadIdx.x, wid = __builtin_amdgcn_readfirstlane(tid >> 6), lane = tid & 63, wr = wid >> 2, wc = wid & 3, fr = lane & 15, fq = lane >> 4;
    const int K = g.K, nt = K / BK;
    unsigned voffA[2], voffB[2];
#pragma unroll
    for (int i = 0; i < 2; ++i) { int R, C; stage_rc(tid * 16 + i * 8192, R, C); const int Rb = 64 * (R >> 5) + perm32(R & 31);
        voffA[i] = (unsigned)(R * K + C) * 2u; voffB[i] = (unsigned)(Rb * K + C) * 2u; }
    const size_t kstep = (size_t)(BK * 2);
    const size_t hstep = (size_t)HALF * K * 2;
    const size_t hstepB = (size_t)32 * K * 2;
    const size_t tstep = 2 * hstep;
    const unsigned ldsw = (unsigned)wid * 1024u;
    const int aoff = lds_byte(wr * 64 + fr, fq * 8), boff = lds_byte(wc * 32 + fr, fq * 8);
#define PG8_SA(b, h) (((b) * 2 + (h)) * HTB)
#define PG8_SB(b, h) ((4 + (b) * 2 + (h)) * HTB)
#define PG8_STAGE(bufoff, gbase, voff) do { _Pragma("unroll") for (int _i = 0; _i < 2; ++_i) \
        __builtin_amdgcn_global_load_lds((const unsigned*)((const char*)(gbase) + (voff)[_i]), (LAS unsigned*)(lds + (bufoff) + ldsw + _i * 8192), 16, 0, 0); } while (0)
#define PG8_LDA(dst, b, h) do { _Pragma("unroll") for (int m = 0; m < 4; ++m) _Pragma("unroll") for (int k = 0; k < 2; ++k) dst[m][k] = *(const LAS bf16x8*)(lds + PG8_SA(b, h) + aoff + m * 2048 + k * 1024); } while (0)
#define PG8_LDB(dst, b, h) do { _Pragma("unroll") for (int n = 0; n < 2; ++n) _Pragma("unroll") for (int k = 0; k < 2; ++k) dst[n][k] = *(const LAS bf16x8*)(lds + PG8_SB(b, h) + boff + n * 2048 + k * 1024); } while (0)
#define PG8_MMA(ai, bj, At, Bt) do { __builtin_amdgcn_s_setprio(1); _Pragma("unroll") for (int m = 0; m < 4; ++m) _Pragma("unroll") for (int n = 0; n < 2; ++n) _Pragma("unroll") for (int k = 0; k < 2; ++k) \
        acc[ai][bj][m][n] = __builtin_amdgcn_mfma_f32_16x16x32_bf16(Bt[n][k], At[m][k], acc[ai][bj][m][n], 0, 0, 0); __builtin_amdgcn_s_setprio(0); } while (0)
#define PG8_WAIT_V(n) asm volatile("s_waitcnt vmcnt(" #n ")" ::: "memory")
#define PG8_WAIT_L(n) asm volatile("s_waitcnt lgkmcnt(" #n ")" ::: "memory")
#define PG8_BAR __builtin_amdgcn_s_barrier()
#define PG8_SCHED __builtin_amdgcn_sched_barrier(0)
    Unit cur, nxt; int ui = 0;
    if (!S.next(0, cur)) return;
    f32x4 acc[2][2][4][2];
#pragma unroll
    for (int a = 0; a < 2; ++a)
#pragma unroll
        for (int b = 0; b < 2; ++b)
#pragma unroll
            for (int m = 0; m < 4; ++m)
#pragma unroll
                for (int n = 0; n < 2; ++n) acc[a][b][m][n] = (f32x4){0.f, 0.f, 0.f, 0.f};
    bf16x8 At[4][2], B0[2][2], B1[2][2];
    const char* cA = (const char*)g.A + (size_t)cur.pm * tstep; const char* cB = (const char*)g.Bt + (size_t)cur.pn * tstep;
    PG8_STAGE(PG8_SB(0, 0), cB, voffB); PG8_STAGE(PG8_SB(0, 1), cB + hstepB, voffB); PG8_STAGE(PG8_SA(0, 0), cA, voffA); PG8_STAGE(PG8_SA(0, 1), cA + hstep, voffA);
    if (wr == 1) PG8_BAR;
    PG8_WAIT_V(2); PG8_BAR;
    PG8_STAGE(PG8_SB(1, 0), cB + kstep, voffB); PG8_STAGE(PG8_SA(1, 0), cA + kstep, voffA); PG8_STAGE(PG8_SB(1, 1), cB + hstepB + kstep, voffB);
    PG8_WAIT_V(6); PG8_BAR;
    for (;;) {
        const bool has_next = S.next(ui + 1, nxt);
        const char* nA = has_next ? (const char*)g.A + (size_t)nxt.pm * tstep : cA; const char* nB = has_next ? (const char*)g.Bt + (size_t)nxt.pn * tstep : cB;
        for (int t = 0; t < nt; t += 2) {
            const bool last = (t == nt - 2);
            const char* a1 = cA + (size_t)(t + 1) * kstep;
            const char* a2 = last ? nA : cA + (size_t)(t + 2) * kstep; const char* b2 = last ? nB : cB + (size_t)(t + 2) * kstep;
            const char* a3 = a2 + kstep; const char* b3 = b2 + kstep;
            PG8_LDB(B0, 0, 0); PG8_LDB(B1, 0, 1); PG8_SCHED; PG8_LDA(At, 0, 0); PG8_STAGE(PG8_SA(1, 1), a1 + hstep, voffA);
            PG8_WAIT_V(8); PG8_WAIT_L(0); PG8_BAR; PG8_MMA(0, 0, At, B0); PG8_MMA(0, 1, At, B1); PG8_BAR; PG8_SCHED;
            PG8_LDA(At, 0, 1); PG8_STAGE(PG8_SB(0, 0), b2, voffB); PG8_STAGE(PG8_SB(0, 1), b2 + hstepB, voffB); PG8_STAGE(PG8_SA(0, 0), a2, voffA);
            PG8_WAIT_V(8); PG8_WAIT_L(0); PG8_BAR; PG8_MMA(1, 0, At, B0); PG8_MMA(1, 1, At, B1); PG8_BAR; PG8_SCHED;
            PG8_LDB(B0, 1, 0); PG8_LDB(B1, 1, 1); PG8_SCHED; PG8_LDA(At, 1, 0); PG8_STAGE(PG8_SA(0, 1), a2 + hstep, voffA);
            PG8_WAIT_V(8); PG8_WAIT_L(0); PG8_BAR; PG8_MMA(0, 0, At, B0); PG8_MMA(0, 1, At, B1); PG8_BAR; PG8_SCHED;
            PG8_LDA(At, 1, 1); PG8_STAGE(PG8_SB(1, 0), b3, voffB); PG8_STAGE(PG8_SB(1, 1), b3 + hstepB, voffB); PG8_STAGE(PG8_SA(1, 0), a3, voffA);
            PG8_WAIT_V(8); PG8_WAIT_L(0); PG8_BAR; PG8_MMA(1, 0, At, B0); PG8_MMA(1, 1, At, B1); PG8_BAR; PG8_SCHED;
        }
        if (wr == 0) PG8_BAR;
        E(acc, cur, wr, wc, fr, fq);
        if (!has_next) break;
#pragma unroll
        for (int a = 0; a < 2; ++a)
#pragma unroll
            for (int b = 0; b < 2; ++b)
#pragma unroll
                for (int m = 0; m < 4; ++m)
#pragma unroll
                    for (int n = 0; n < 2; ++n) acc[a][b][m][n] = (f32x4){0.f, 0.f, 0.f, 0.f};
        cur = nxt; cA = nA; cB = nB; ++ui;
        if (wr == 1) PG8_BAR;
    }
    PG8_WAIT_V(0);
    PG8_BAR;
#undef PG8_SA
#undef PG8_SB
#undef PG8_STAGE
#undef PG8_LDA
#undef PG8_LDB
#undef PG8_MMA
#undef PG8_WAIT_V
#undef PG8_WAIT_L
#undef PG8_BAR
#undef PG8_SCHED
}
}

struct EpiIn {
    unsigned char* ws;
    const float *qnw, *knw, *rope;
    DI void operator()(const f32x4 (&acc)[2][2][4][2], const pg8::Unit& u, int wr, int wc, int fr, int fq) const {
        const int grp = u.pn >> 2, sub = u.pn & 3;
        const int row0 = u.pm * 256 + wr * 64 + fr;
        const int b = row0 >> 12, i0 = row0 & 4095;
        const int head = sub * 2 + (wc >> 1), bh = b * NH + head;
        const int dcol = 64 * (wc & 1) + 8 * fq;
        if (grp == 3 || grp == 7) {
            bf16_t* base = (bf16_t*)(ws + WS_G) + (size_t)row0 * DM + (grp == 7 ? 1024 : 0) + sub * 256 + 64 * wc + 8 * fq;
#pragma unroll
            for (int ai = 0; ai < 2; ++ai)
#pragma unroll
                for (int m = 0; m < 4; ++m)
#pragma unroll
                    for (int bj = 0; bj < 2; ++bj) { const f32x4 v0 = acc[ai][bj][m][0], v1 = acc[ai][bj][m][1]; u32x4 w;
                        w.x = cvt_pk_bf16(silu_f(v0[0]), silu_f(v0[1])); w.y = cvt_pk_bf16(silu_f(v0[2]), silu_f(v0[3]));
                        w.z = cvt_pk_bf16(silu_f(v1[0]), silu_f(v1[1])); w.w = cvt_pk_bf16(silu_f(v1[2]), silu_f(v1[3]));
                        __builtin_nontemporal_store(w, (u32x4*)(base + (size_t)(ai * 128 + m * 16) * DM + bj * 32)); }
        } else if (grp == 4 || grp == 5) {
            const float* nw = (grp == 4) ? qnw : knw;
            const float sc = (grp == 4) ? LOG2E * 0.125f : 1.f;
            const size_t eoff = (grp == 4) ? ((size_t)bh * SEQ + i0) * HD + dcol : ((size_t)bh * TPAD + 64 + i0) * HD + dcol;
            bf16_t* base = (bf16_t*)(ws + ((grp == 4) ? WS_DFQ : WS_DFK)) + eoff;
            f32x4 wv[2][2];
#pragma unroll
            for (int bj = 0; bj < 2; ++bj)
#pragma unroll
                for (int n = 0; n < 2; ++n) wv[bj][n] = *(const f32x4*)(nw + 32 * bj + 8 * fq + 4 * n);
#pragma unroll
            for (int am = 0; am < 4; ++am) { const int ai = am >> 1;
                f32x4 csn[4][2][2];
#pragma unroll
                for (int m = 2 * (am & 1); m < 2 * (am & 1) + 2; ++m) { const float* rt = rope + (size_t)(NMETA + i0 + ai * 128 + m * 16) * 16;
#pragma unroll
                    for (int n = 0; n < 2; ++n) { csn[m][n][0] = *(const f32x4*)(rt + 4 * n); csn[m][n][1] = *(const f32x4*)(rt + 8 + 4 * n); } }
#pragma unroll
                for (int m = 2 * (am & 1); m < 2 * (am & 1) + 2; ++m) {
                    f32x4 v[2][2]; float ss = 0.f;
#pragma unroll
                    for (int bj = 0; bj < 2; ++bj)
#pragma unroll
                        for (int n = 0; n < 2; ++n) { v[bj][n] = acc[ai][bj][m][n]; const f32x4 q = v[bj][n] * v[bj][n]; ss += (q[0] + q[1]) + (q[2] + q[3]); }
                    ss += __shfl_xor(ss, 16); ss += __shfl_xor(ss, 32);
                    const float rstd = __builtin_amdgcn_rsqf(ss * (1.f / 64.f) + RMS_EPS);
#pragma unroll
                    for (int bj = 0; bj < 2; ++bj)
#pragma unroll
                        for (int n = 0; n < 2; ++n) v[bj][n] = v[bj][n] * rstd * wv[bj][n];
#pragma unroll
                    for (int n = 0; n < 2; ++n) { const f32x4 cs = csn[m][n][0], sn = csn[m][n][1];
                        f32x4 pr; pr[0] = __shfl_xor(v[0][n][0], 16); pr[1] = __shfl_xor(v[0][n][1], 16); pr[2] = __shfl_xor(v[0][n][2], 16); pr[3] = __shfl_xor(v[0][n][3], 16);
                        const f32x4 x = v[0][n];
                        if (fq == 0) v[0][n] = x * cs - pr * sn; else if (fq == 1) v[0][n] = x * cs + pr * sn; }
#pragma unroll
                    for (int bj = 0; bj < 2; ++bj) { const f32x4 v0 = v[bj][0] * sc, v1 = v[bj][1] * sc; u32x4 w;
                        w.x = cvt_pk_bf16(v0[0], v0[1]); w.y = cvt_pk_bf16(v0[2], v0[3]); w.z = cvt_pk_bf16(v1[0], v1[1]); w.w = cvt_pk_bf16(v1[2], v1[3]);
                        *(u32x4*)(base + (size_t)(ai * 128 + m * 16) * HD + bj * 32) = w; }
                }
            }
        } else {
            const float sc = (grp == 0) ? -LOG2E * 0.08838834764831845f : 1.f;
            const size_t eoff = (grp == 0) ? ((size_t)bh * SEQ + i0) * HD + dcol : ((size_t)bh * TPAD + 64 + i0) * HD + dcol;
            size_t aoff = WS_SBQ; if (grp == 1) aoff = WS_SBK; if (grp == 2) aoff = WS_SBV; if (grp == 6) aoff = WS_DFV;
            bf16_t* base = (bf16_t*)(ws + aoff) + eoff;
#pragma unroll
            for (int ai = 0; ai < 2; ++ai)
#pragma unroll
                for (int m = 0; m < 4; ++m)
#pragma unroll
                    for (int bj = 0; bj < 2; ++bj) { const f32x4 v0 = acc[ai][bj][m][0] * sc, v1 = acc[ai][bj][m][1] * sc; u32x4 w;
                        w.x = cvt_pk_bf16(v0[0], v0[1]); w.y = cvt_pk_bf16(v0[2], v0[3]); w.z = cvt_pk_bf16(v1[0], v1[1]); w.w = cvt_pk_bf16(v1[2], v1[3]);
                        *(u32x4*)(base + (size_t)(ai * 128 + m * 16) * HD + bj * 32) = w; }
        }
    }
};
struct EpiOut {
    const float* x; float* out;
    DI void operator()(const f32x4 (&acc)[2][2][4][2], const pg8::Unit& u, int wr, int wc, int fr, int fq) const {
        const size_t off0 = (size_t)(u.pm * 256 + wr * 64 + fr) * DM + u.pn * 256 + 64 * wc + 8 * fq;
#pragma unroll
        for (int ai = 0; ai < 2; ++ai) {
            f32x4 xv[4][2][2];
#pragma unroll
            for (int m = 0; m < 4; ++m)
#pragma unroll
                for (int bj = 0; bj < 2; ++bj) { const size_t off = off0 + (size_t)(ai * 128 + m * 16) * DM + bj * 32;
                    xv[m][bj][0] = *(const f32x4*)(x + off); xv[m][bj][1] = *(const f32x4*)(x + off + 4); }
#pragma unroll
            for (int m = 0; m < 4; ++m)
#pragma unroll
                for (int bj = 0; bj < 2; ++bj) { const size_t off = off0 + (size_t)(ai * 128 + m * 16) * DM + bj * 32;
                    *(f32x4*)(out + off) = xv[m][bj][0] + acc[ai][bj][m][0]; *(f32x4*)(out + off + 4) = xv[m][bj][1] + acc[ai][bj][m][1]; }
        }
    }
};

namespace att {
constexpr int SHM_V = 16384, SHM_K = 16384;
constexpr int L_V = 0, L_K = 2 * SHM_V, L_Q = 65536, L_WS = 131072 + 4096, L_CTRL = 131072 + 4096 + 2048;
#define KSWZ(row, colB) ((row) * 256 + ((colB) ^ (((row) & 7) << 4)))
#define SBAR() __builtin_amdgcn_sched_barrier(0)
DI int v_st(int k, int c) { const int kk = (k & ~0xC) | ((k & 4) << 1) | ((k & 8) >> 1); return ((kk >> 3) * 4 + (c >> 5)) * 512 + ((kk & 7) * 32 + (c & 31)) * 2; }
DI int v_rd_base(int lane) { return ((lane & 3) << 3) | (((lane >> 2) & 3) << 6) | (((lane >> 4) & 1) << 5) | (((lane >> 5) & 1) << 8); }
constexpr int v_rd_off(int d0, int ks, int half) { return d0 * 512 + ks * 4096 + half * 2048; }
DI int crow(int r, int hi) { return (r & 3) + 8 * (r >> 2) + 4 * hi; }

DI void glds16s(const void* sbase, unsigned voff, unsigned lds_dst) {
    unsigned keep;
    asm volatile("s_mov_b32 %0, m0\n\ts_mov_b32 m0, %3\n\ts_nop 0\n\tglobal_load_lds_dwordx4 %1, %2\n\ts_mov_b32 m0, %0" : "=&s"(keep) : "v"(voff), "s"(sbase), "s"(lds_dst) : "memory");
}
template <int NK>
DI void qkt(f32x16& p0, f32x16& p1, LAS const unsigned char* Kb, int r32, int hi, int cofs, const bf16x8* qr, float cinit) {
#pragma unroll
    for (int r = 0; r < 16; ++r) { p0[r] = cinit; p1[r] = cinit; }
    LAS const unsigned char* kb[4];
#pragma unroll
    for (int dd = 0; dd < 4; ++dd) kb[dd] = Kb + KSWZ(r32, (dd * 16 + hi * 8) * 2) + cofs;
#pragma unroll
    for (int d0 = 0; d0 < NK; ++d0) { LAS const unsigned char* a = kb[d0 & 3] + (d0 >> 2) * 128;
        const bf16x8 b0 = *(LAS const bf16x8*)a, b1 = *(LAS const bf16x8*)(a + 32 * 256);
        p0 = __builtin_amdgcn_mfma_f32_32x32x16_bf16(b0, qr[d0], p0, 0, 0, 0);
        p1 = __builtin_amdgcn_mfma_f32_32x32x16_bf16(b1, qr[d0], p1, 0, 0, 0); }
}
DI void qkt_lq(f32x16& p0, f32x16& p1, LAS const unsigned char* Kb, LAS const unsigned char* Qw, int r32, int hi, int cofs) {
    f32x16 z;
#pragma unroll
    for (int r = 0; r < 16; ++r) z[r] = 0.f;
    bf16x8 b0[2], b1[2], q[2];
#define LDF(d0_, sl) do { const int off = KSWZ(r32, ((d0_) * 16 + hi * 8) * 2) + cofs; \
        b0[sl] = *(LAS const bf16x8*)(Kb + off); b1[sl] = *(LAS const bf16x8*)(Kb + off + 32 * 256); q[sl] = *(LAS const bf16x8*)(Qw + off); } while (0)
    LDF(0, 0);
#pragma unroll
    for (int d0 = 0; d0 < 4; ++d0) {
        if (d0 < 3) LDF(d0 + 1, (d0 + 1) & 1);
        if (d0 == 0) { p0 = __builtin_amdgcn_mfma_f32_32x32x16_bf16(b0[0], q[0], z, 0, 0, 0); p1 = __builtin_amdgcn_mfma_f32_32x32x16_bf16(b1[0], q[0], z, 0, 0, 0); }
        else { p0 = __builtin_amdgcn_mfma_f32_32x32x16_bf16(b0[d0 & 1], q[d0 & 1], p0, 0, 0, 0); p1 = __builtin_amdgcn_mfma_f32_32x32x16_bf16(b1[d0 & 1], q[d0 & 1], p1, 0, 0, 0); }
    }
#undef LDF
}
DI void pv_tile(f32x16* o, int vb0, bf16x8 pa0, bf16x8 pa1, bf16x8 pa2, bf16x8 pa3) {
#define TRRD(dst, off) asm volatile("ds_read_b64_tr_b16 %0, %1 offset:%2" : "=&v"(dst) : "v"(vb0), "i"(off) : "memory")
#define PV_D0(d0) do { s16x4 l0, l1, l2, l3, h0, h1, h2, h3; constexpr int b_ = v_rd_off(d0, 0, 0); \
        TRRD(l0, b_); TRRD(h0, b_ + 2048); TRRD(l1, b_ + 4096); TRRD(h1, b_ + 6144); TRRD(l2, b_ + 8192); TRRD(h2, b_ + 10240); TRRD(l3, b_ + 12288); TRRD(h3, b_ + 14336); \
        asm volatile("s_waitcnt lgkmcnt(0)" ::: "memory"); SBAR(); \
        o[d0] = __builtin_amdgcn_mfma_f32_32x32x16_bf16(pa0, (bf16x8){l0[0], l0[1], l0[2], l0[3], h0[0], h0[1], h0[2], h0[3]}, o[d0], 0, 0, 0); \
        o[d0] = __builtin_amdgcn_mfma_f32_32x32x16_bf16(pa1, (bf16x8){l1[0], l1[1], l1[2], l1[3], h1[0], h1[1], h1[2], h1[3]}, o[d0], 0, 0, 0); \
        o[d0] = __builtin_amdgcn_mfma_f32_32x32x16_bf16(pa2, (bf16x8){l2[0], l2[1], l2[2], l2[3], h2[0], h2[1], h2[2], h2[3]}, o[d0], 0, 0, 0); \
        o[d0] = __builtin_amdgcn_mfma_f32_32x32x16_bf16(pa3, (bf16x8){l3[0], l3[1], l3[2], l3[3], h3[0], h3[1], h3[2], h3[3]}, o[d0], 0, 0, 0); } while (0)
    PV_D0(0); PV_D0(1); PV_D0(2); PV_D0(3);
#undef PV_D0
#undef TRRD
}
DI void pv_tile_db(f32x16* o, int vb0, bf16x8 pa0, bf16x8 pa1, bf16x8 pa2, bf16x8 pa3) {
#define TRRD(dst, off) asm volatile("ds_read_b64_tr_b16 %0, %1 offset:%2" : "=&v"(dst) : "v"(vb0), "i"(off) : "memory")
#define VLD(S, d0) do { constexpr int b_ = v_rd_off(d0, 0, 0); TRRD(S##l0, b_); TRRD(S##h0, b_ + 2048); TRRD(S##l1, b_ + 4096); TRRD(S##h1, b_ + 6144); \
        TRRD(S##l2, b_ + 8192); TRRD(S##h2, b_ + 10240); TRRD(S##l3, b_ + 12288); TRRD(S##h3, b_ + 14336); } while (0)
#define LWAIT(n) do { asm volatile("s_waitcnt lgkmcnt(" #n ")" ::: "memory"); SBAR(); } while (0)
#define VF(l, h) (bf16x8){l[0], l[1], l[2], l[3], h[0], h[1], h[2], h[3]}
#define PVX(S, d0) do { \
        o[d0] = __builtin_amdgcn_mfma_f32_32x32x16_bf16(pa0, VF(S##l0, S##h0), o[d0], 0, 0, 0); o[d0] = __builtin_amdgcn_mfma_f32_32x32x16_bf16(pa1, VF(S##l1, S##h1), o[d0], 0, 0, 0); \
        o[d0] = __builtin_amdgcn_mfma_f32_32x32x16_bf16(pa2, VF(S##l2, S##h2), o[d0], 0, 0, 0); o[d0] = __builtin_amdgcn_mfma_f32_32x32x16_bf16(pa3, VF(S##l3, S##h3), o[d0], 0, 0, 0); SBAR(); } while (0)
    s16x4 Al0, Al1, Al2, Al3, Ah0, Ah1, Ah2, Ah3, Bl0, Bl1, Bl2, Bl3, Bh0, Bh1, Bh2, Bh3;
    VLD(A, 0);
    VLD(B, 1); LWAIT(8); PVX(A, 0);
    VLD(A, 2); LWAIT(8); PVX(B, 1);
    VLD(B, 3); LWAIT(8); PVX(A, 2);
    LWAIT(0); PVX(B, 3);
#undef PVX
#undef VF
#undef LWAIT
#undef VLD
#undef TRRD
}
DI void pack_p(const f32x16& p0, const f32x16& p1, bf16x8& pa0, bf16x8& pa1, bf16x8& pa2, bf16x8& pa3) {
#define PK4(P, B_, OUT) do { u32x4 w = {cvt_pk_bf16(P[B_+0], P[B_+1]), cvt_pk_bf16(P[B_+2], P[B_+3]), cvt_pk_bf16(P[B_+4], P[B_+5]), cvt_pk_bf16(P[B_+6], P[B_+7])}; \
        OUT = __builtin_bit_cast(bf16x8, w); } while (0)
    PK4(p0, 0, pa0); PK4(p0, 8, pa1); PK4(p1, 0, pa2); PK4(p1, 8, pa3);
#undef PK4
}
struct Ptrs { const bf16_t *sbQ, *sbK, *sbV, *dfQ, *dfK, *dfV, *G; bf16_t* MIX; const float* subw; float lam, boff; };

DI void pv_tile2(f32x16* o, int vb0, const bf16x8* pa, const bf16x8* pb) {
#define TRRD(dst, off) asm volatile("ds_read_b64_tr_b16 %0, %1 offset:%2" : "=&v"(dst) : "v"(vb0), "i"(off) : "memory")
#define PV_D0(d0) do { s16x4 l0, l1, l2, l3, h0, h1, h2, h3; constexpr int b_ = v_rd_off(d0, 0, 0); \
        TRRD(l0, b_); TRRD(h0, b_ + 2048); TRRD(l1, b_ + 4096); TRRD(h1, b_ + 6144); TRRD(l2, b_ + 8192); TRRD(h2, b_ + 10240); TRRD(l3, b_ + 12288); TRRD(h3, b_ + 14336); \
        asm volatile("s_waitcnt lgkmcnt(0)" ::: "memory"); SBAR(); \
        const bf16x8 v0 = (bf16x8){l0[0], l0[1], l0[2], l0[3], h0[0], h0[1], h0[2], h0[3]}, v1 = (bf16x8){l1[0], l1[1], l1[2], l1[3], h1[0], h1[1], h1[2], h1[3]}; \
        const bf16x8 v2 = (bf16x8){l2[0], l2[1], l2[2], l2[3], h2[0], h2[1], h2[2], h2[3]}, v3 = (bf16x8){l3[0], l3[1], l3[2], l3[3], h3[0], h3[1], h3[2], h3[3]}; \
        o[d0] = __builtin_amdgcn_mfma_f32_32x32x16_bf16(pa[0], v0, o[d0], 0, 0, 0); o[4 + d0] = __builtin_amdgcn_mfma_f32_32x32x16_bf16(pb[0], v0, o[4 + d0], 0, 0, 0); \
        o[d0] = __builtin_amdgcn_mfma_f32_32x32x16_bf16(pa[1], v1, o[d0], 0, 0, 0); o[4 + d0] = __builtin_amdgcn_mfma_f32_32x32x16_bf16(pb[1], v1, o[4 + d0], 0, 0, 0); \
        o[d0] = __builtin_amdgcn_mfma_f32_32x32x16_bf16(pa[2], v2, o[d0], 0, 0, 0); o[4 + d0] = __builtin_amdgcn_mfma_f32_32x32x16_bf16(pb[2], v2, o[4 + d0], 0, 0, 0); \
        o[d0] = __builtin_amdgcn_mfma_f32_32x32x16_bf16(pa[3], v3, o[d0], 0, 0, 0); o[4 + d0] = __builtin_amdgcn_mfma_f32_32x32x16_bf16(pb[3], v3, o[4 + d0], 0, 0, 0); } while (0)
    PV_D0(0); PV_D0(1); PV_D0(2); PV_D0(3);
#undef PV_D0
#undef TRRD
}
template <int DF, int VAR = 0>
DI void attn_unit(const Ptrs& P, int bh, int qb, LAS unsigned char* lds) {
    int tid = threadIdx.x; asm volatile("" : "+v"(tid));
    const int wid = __builtin_amdgcn_readfirstlane(tid >> 6), lane = tid & 63, r32 = lane & 31, hi = lane >> 5;
    constexpr int QROWS = 256, INCL = DF ? 1 : 0, NO = DF ? 8 : 4;
    const int i0 = qb * QROWS;
    const int qlo = i0 + 32 * wid, b = bh >> 3, h = bh & 7;
    const bf16_t* Qh = (DF ? P.dfQ : P.sbQ) + (size_t)bh * SEQ * HD;
    const bf16_t* Kh = (DF ? P.dfK : P.sbK) + (size_t)bh * TPAD * HD;
    const bf16_t* Vh = (DF ? P.dfV : P.sbV) + (size_t)bh * TPAD * HD;
    const int NT = (i0 + QROWS) / 64 + 1;
    LAS unsigned char* V_lds = lds + L_V; LAS unsigned char* K_lds = lds + L_K;
    LAS float* wsf = (LAS float*)(lds + L_WS) + wid * 64;
    LAS unsigned* eflag = (LAS unsigned*)(lds + L_CTRL) + 16;
    bf16x8 qr[8];
    LAS unsigned char* Q_lds = lds + L_Q + wid * 8192;
    if (DF) {
#pragma unroll
        for (int i = 0; i < 8; ++i) { const int p = i * 64 + lane, row = p >> 4, cs = p & 15, c = cs ^ (row & 7);
            glds16s(Qh + (size_t)qlo * HD, (unsigned)(row * HD + c * 8) * 2u, (unsigned)__builtin_amdgcn_readfirstlane((unsigned)(uintptr_t)Q_lds + i * 1024)); }
    } else {
#pragma unroll
        for (int d0 = 0; d0 < 8; ++d0) qr[d0] = *(const bf16x8*)(Qh + (size_t)(qlo + r32) * HD + d0 * 16 + hi * 8);
    }
    const int vbase = (int)(unsigned)(uintptr_t)V_lds + v_rd_base(lane);
    unsigned koff[2], voff[2];
#pragma unroll
    for (int i = 0; i < 2; ++i) { const int p = (i * 8 + wid) * 64 + lane;
        { const int row = p >> 4, cs = p & 15, c = cs ^ (row & 7); koff[i] = (unsigned)(row * HD + c * 8) * 2u; }
        { const int st = p >> 5, kk = (st >> 2) * 8 + ((p & 31) >> 2), k = kk  , c = (st & 3) * 32 + (p & 3) * 8; voff[i] = (unsigned)(k * HD + c) * 2u; } }
    const unsigned ldsK0 = (unsigned)(uintptr_t)K_lds + wid * 1024, ldsV0 = (unsigned)(uintptr_t)V_lds + wid * 1024;
#define DMA(kt_, bf) do { const char* kb_ = (const char*)(Kh + (size_t)(kt_) * 64 * HD); const char* vb_ = (const char*)(Vh + (size_t)(kt_) * 64 * HD); \
        _Pragma("unroll") for (int _i = 0; _i < 2; ++_i) { \
            glds16s(kb_, koff[_i], (unsigned)__builtin_amdgcn_readfirstlane(ldsK0 + (bf) * SHM_K + _i * 8192)); \
            glds16s(vb_, voff[_i], (unsigned)__builtin_amdgcn_readfirstlane(ldsV0 + (bf) * SHM_V + _i * 8192)); } } while (0)
    f32x16 o[NO];
#pragma unroll
    for (int d = 0; d < NO; ++d)
#pragma unroll
        for (int r = 0; r < 16; ++r) o[d][r] = 0.f;
    bool wdone = false;
    float carry = 1.f, lsum0 = 0.f, lsum1 = 0.f;
    DMA(DF ? 0 : NT - 1, 0);
    asm volatile("s_waitcnt vmcnt(0)" ::: "memory");
    if (!DF) {
#pragma unroll
        for (int d0 = 0; d0 < 8; ++d0) asm volatile("" : "+v"(qr[d0]));
    }
    __syncthreads();
    for (int it = 0; it < NT; ++it) {
        const int kt = DF ? it : NT - 1 - it, buf = it & 1;
        if (it + 1 < NT && !(VAR & 2)) DMA(DF ? kt + 1 : kt - 1, buf ^ 1);
        const int j0 = 64 * (kt - 1);
        const bool act = (kt == 0) || (j0 < qlo + 31 + INCL);
        const bool need_mask = (kt == 0) || (j0 + 63 >= qlo + INCL);
        if (act && !(VAR & 4) && !(!DF && SB_EARLY_EXIT && wdone)) {
            const int thi = qlo + r32 - j0 + INCL - 4 * hi;
            if (DF) {
                LAS const unsigned char* Kb = K_lds + buf * SHM_K;
                const int vb0 = vbase + buf * SHM_V;
                f32x16 s0a, s0b, s1a, s1b;
                qkt_lq(s0a, s0b, Kb, Q_lds, r32, hi, 0);
                SBAR();
                {
                    f32x16 z;
#pragma unroll
                    for (int r = 0; r < 16; ++r) z[r] = 0.f;
                    bf16x8 kb0[2], kb1[2], qf[2];
#define LDF(d0_, sl) do { const int off = KSWZ(r32, ((d0_) * 16 + hi * 8) * 2) + 128; \
                        kb0[sl] = *(LAS const bf16x8*)(Kb + off); kb1[sl] = *(LAS const bf16x8*)(Kb + off + 32 * 256); qf[sl] = *(LAS const bf16x8*)(Q_lds + off); } while (0)
                    LDF(0, 0);
#pragma unroll
                    for (int d0 = 0; d0 < 4; ++d0) {
                        if (d0 < 3) LDF(d0 + 1, (d0 + 1) & 1);
                        SBAR();
                        if (d0 == 0) s1a = __builtin_amdgcn_mfma_f32_32x32x16_bf16(kb0[0], qf[0], z, 0, 0, 0); else s1a = __builtin_amdgcn_mfma_f32_32x32x16_bf16(kb0[d0 & 1], qf[d0 & 1], s1a, 0, 0, 0);
#pragma unroll
                        for (int j = 0; j < 4; ++j) if (!(VAR & 32)) s0a[4 * d0 + j] = __builtin_amdgcn_exp2f(s0a[4 * d0 + j]);
                        SBAR();
                        if (d0 == 0) s1b = __builtin_amdgcn_mfma_f32_32x32x16_bf16(kb1[0], qf[0], z, 0, 0, 0); else s1b = __builtin_amdgcn_mfma_f32_32x32x16_bf16(kb1[d0 & 1], qf[d0 & 1], s1b, 0, 0, 0);
#pragma unroll
                        for (int j = 0; j < 4; ++j) if (!(VAR & 32)) s0b[4 * d0 + j] = __builtin_amdgcn_exp2f(s0b[4 * d0 + j]);
                        SBAR();
                    }
#undef LDF
                }
#define DF_MASK(PA, PB) do { if (need_mask) { if (kt == 0) { _Pragma("unroll") for (int r = 0; r < 16; ++r) { PA[r] = 0.f; if (r < 8) PB[r] = 0.f; } } \
                    else { _Pragma("unroll") for (int r = 0; r < 16; ++r) { const int c = (r & 3) + 8 * (r >> 2); if (c >= thi) PA[r] = 0.f; if (c + 32 >= thi) PB[r] = 0.f; } } } } while (0)
                bf16x8 pa[4];
                { DF_MASK(s0a, s0b); float ps = 0.f;
                  { float t_[16];
                    _Pragma("unroll") for (int r = 0; r < 16; ++r) t_[r] = s0a[r] + s0b[r];
                    _Pragma("unroll") for (int w_ = 8; w_ >= 1; w_ >>= 1) { _Pragma("unroll") for (int r = 0; r < w_; ++r) t_[r] += t_[r + w_]; }
                    ps = t_[0]; }
                  asm volatile("" : "+v"(ps)); lsum0 += ps; pack_p(s0a, s0b, pa[0], pa[1], pa[2], pa[3]); }
                SBAR();
#define TRRD(dst, off) asm volatile("ds_read_b64_tr_b16 %0, %1 offset:%2" : "=&v"(dst) : "v"(vb0), "i"(off) : "memory")
#define VFRAG(l, h) (bf16x8){l[0], l[1], l[2], l[3], h[0], h[1], h[2], h[3]}
#define EXP2(X, B_) do { if (!(VAR & 32)) { X[B_] = __builtin_amdgcn_exp2f(X[B_]); X[B_ + 1] = __builtin_amdgcn_exp2f(X[B_ + 1]); } } while (0)
#define VLD(S, d0) do { constexpr int b_ = v_rd_off(d0, 0, 0); TRRD(S##l0, b_); TRRD(S##h0, b_ + 2048); TRRD(S##l1, b_ + 4096); TRRD(S##h1, b_ + 6144); \
        TRRD(S##l2, b_ + 8192); TRRD(S##h2, b_ + 10240); TRRD(S##l3, b_ + 12288); TRRD(S##h3, b_ + 14336); } while (0)
#define LWAIT(n) do { asm volatile("s_waitcnt lgkmcnt(" #n ")" ::: "memory"); SBAR(); } while (0)
#define PVA(S, d0, SX, EB) do { \
        o[d0] = __builtin_amdgcn_mfma_f32_32x32x16_bf16(pa[0], VFRAG(S##l0, S##h0), o[d0], 0, 0, 0); EXP2(SX, EB); SBAR(); \
        o[d0] = __builtin_amdgcn_mfma_f32_32x32x16_bf16(pa[1], VFRAG(S##l1, S##h1), o[d0], 0, 0, 0); EXP2(SX, EB + 2); SBAR(); \
        o[d0] = __builtin_amdgcn_mfma_f32_32x32x16_bf16(pa[2], VFRAG(S##l2, S##h2), o[d0], 0, 0, 0); EXP2(SX, EB + 4); SBAR(); \
        o[d0] = __builtin_amdgcn_mfma_f32_32x32x16_bf16(pa[3], VFRAG(S##l3, S##h3), o[d0], 0, 0, 0); EXP2(SX, EB + 6); SBAR(); } while (0)
#define PVB(S, d0) do { \
        o[4 + d0] = __builtin_amdgcn_mfma_f32_32x32x16_bf16(pb[0], VFRAG(S##l0, S##h0), o[4 + d0], 0, 0, 0); \
        o[4 + d0] = __builtin_amdgcn_mfma_f32_32x32x16_bf16(pb[1], VFRAG(S##l1, S##h1), o[4 + d0], 0, 0, 0); \
        o[4 + d0] = __builtin_amdgcn_mfma_f32_32x32x16_bf16(pb[2], VFRAG(S##l2, S##h2), o[4 + d0], 0, 0, 0); \
        o[4 + d0] = __builtin_amdgcn_mfma_f32_32x32x16_bf16(pb[3], VFRAG(S##l3, S##h3), o[4 + d0], 0, 0, 0); SBAR(); } while (0)
                s16x4 Al0, Al1, Al2, Al3, Ah0, Ah1, Ah2, Ah3, Bl0, Bl1, Bl2, Bl3, Bh0, Bh1, Bh2, Bh3;
                __builtin_amdgcn_s_setprio(1);
                if (!(VAR & 16)) {
                VLD(A, 0);
                VLD(B, 1); LWAIT(8); PVA(A, 0, s1a, 0);
                VLD(A, 2); LWAIT(8); PVA(B, 1, s1a, 8);
                VLD(B, 3); LWAIT(8); PVA(A, 2, s1b, 0);
                VLD(A, 0); LWAIT(8); PVA(B, 3, s1b, 8);
                } else { _Pragma("unroll") for (int r = 0; r < 16; r += 2) { EXP2(s1a, r); EXP2(s1b, r); } if (!(VAR & 8)) VLD(A, 0); }
                bf16x8 pb[4];
                { DF_MASK(s1a, s1b); float ps = 0.f;
                  { float t_[16];
                    _Pragma("unroll") for (int r = 0; r < 16; ++r) t_[r] = s1a[r] + s1b[r];
                    _Pragma("unroll") for (int w_ = 8; w_ >= 1; w_ >>= 1) { _Pragma("unroll") for (int r = 0; r < w_; ++r) t_[r] += t_[r + w_]; }
                    ps = t_[0]; }
                  asm volatile("" : "+v"(ps)); lsum1 += ps; pack_p(s1a, s1b, pb[0], pb[1], pb[2], pb[3]); }
                SBAR();
                if (!(VAR & 8)) {
                VLD(B, 1); LWAIT(8); PVB(A, 0);
                VLD(A, 2); LWAIT(8); PVB(B, 1);
                VLD(B, 3); LWAIT(8); PVB(A, 2);
                LWAIT(0); PVB(B, 3);
                }
                __builtin_amdgcn_s_setprio(0);
#undef VLD
#undef LWAIT
#undef PVA
#undef PVB
#undef PVA_D0
#undef PVB_D0
#undef TRRD
#undef VFRAG
#undef EXP2
#undef DF_MASK
            } else {
                f32x16 p0, p1;
                qkt<8>(p0, p1, K_lds + buf * SHM_K, r32, hi, 0, qr, 0.f);
#pragma unroll
                for (int r = 0; r < 16; ++r) { p0[r] = 1.f - __builtin_amdgcn_rcpf(1.f + __builtin_amdgcn_exp2f(p0[r])); p1[r] = 1.f - __builtin_amdgcn_rcpf(1.f + __builtin_amdgcn_exp2f(p1[r])); }
                if (need_mask) {
                    if (kt == 0) {
#pragma unroll
                        for (int r = 0; r < 16; ++r) { p0[r] = 1.f; if (r < 8) p1[r] = 1.f; }
                    } else {
#pragma unroll
                        for (int r = 0; r < 16; ++r) { const int c = (r & 3) + 8 * (r >> 2);
                            if (c >= thi) p0[r] = 1.f;
                            if (c + 32 >= thi) p1[r] = 1.f; }
                    }
                }
                float Glo[2][4], Ghi[2][4];
#pragma unroll
                for (int g = 0; g < 4; ++g) {
                    const float g0 = (p0[4 * g] * p0[4 * g + 1]) * (p0[4 * g + 2] * p0[4 * g + 3]);
                    const float g1 = (p1[4 * g] * p1[4 * g + 1]) * (p1[4 * g + 2] * p1[4 * g + 3]);
                    auto r0 = __builtin_amdgcn_permlane32_swap(__float_as_uint(g0), __float_as_uint(g0), false, false);
                    auto r1 = __builtin_amdgcn_permlane32_swap(__float_as_uint(g1), __float_as_uint(g1), false, false);
                    Glo[0][g] = __uint_as_float(r0[0]); Ghi[0][g] = __uint_as_float(r0[1]); Glo[1][g] = __uint_as_float(r1[0]); Ghi[1][g] = __uint_as_float(r1[1]);
                }
                float run = carry;
#pragma unroll
                for (int x = 1; x >= 0; --x)
#pragma unroll
                    for (int g = 3; g >= 0; --g) {
                        const float e1 = run; run *= Ghi[x][g]; const float e0 = run; run *= Glo[x][g];
                        float e = hi ? e1 : e0;
#pragma unroll
                        for (int j = 3; j >= 0; --j) {
                            if (x == 0) { const float en = p0[4 * g + j] * e; p0[4 * g + j] = e - en; e = en; }
                            else        { const float en = p1[4 * g + j] * e; p1[4 * g + j] = e - en; e = en; }
                        }
                    }
                carry = run;
                bf16x8 pa0, pa1, pa2, pa3;
                pack_p(p0, p1, pa0, pa1, pa2, pa3);
                __builtin_amdgcn_s_setprio(1);
                pv_tile_db(o, vbase + buf * SHM_V, pa0, pa1, pa2, pa3);
                __builtin_amdgcn_s_setprio(0);
            }
        }
        if (!DF && SB_EARLY_EXIT) { wdone = __all(carry == 0.f); if (lane == 0) eflag[(it & 1) * 8 + wid] = wdone ? 1u : 0u; }
        asm volatile("s_waitcnt vmcnt(0)" ::: "memory");
        __syncthreads();
        if (!DF && SB_EARLY_EXIT) { const u32x4 f0 = *(LAS const u32x4*)(eflag + (it & 1) * 8), f1 = *(LAS const u32x4*)(eflag + (it & 1) * 8 + 4);
            if (((f0.x & f0.y) & (f0.z & f0.w)) & ((f1.x & f1.y) & (f1.z & f1.w))) break; }
    }
#undef DMA
    int lane_e = lane; asm volatile("" : "+v"(lane_e));
    constexpr int SPITCH = 272;
    LAS unsigned char* stg = lds + wid * 8704;
    if (DF) {
        { auto rr = __builtin_amdgcn_permlane32_swap(__float_as_uint(lsum0), __float_as_uint(lsum0), false, false); lsum0 = __uint_as_float(rr[0]) + __uint_as_float(rr[1]); }
        { auto rr = __builtin_amdgcn_permlane32_swap(__float_as_uint(lsum1), __float_as_uint(lsum1), false, false); lsum1 = __uint_as_float(rr[0]) + __uint_as_float(rr[1]); }
        wsf[lane] = hi ? lsum1 : lsum0;
        asm volatile("s_waitcnt lgkmcnt(0)" ::: "memory");
        const float lam = P.lam;
        float ss[16];
#pragma unroll
        for (int r = 0; r < 16; ++r) { const float rl0 = __builtin_amdgcn_rcpf(wsf[crow(r, hi)]), rl1 = lam * __builtin_amdgcn_rcpf(wsf[32 + crow(r, hi)]); float q = 0.f;
#pragma unroll
            for (int d = 0; d < 4; ++d) { const float v = o[d][r] * rl0 - o[NO - 4 + d][r] * rl1; o[d][r] = v; q += v * v; }
            ss[r] = q; }
#pragma unroll
        for (int r = 0; r < 16; ++r) {
            ss[r] += __int_as_float(__builtin_amdgcn_update_dpp(0, __float_as_int(ss[r]), 0xB1, 0xF, 0xF, true));
            ss[r] += __int_as_float(__builtin_amdgcn_update_dpp(0, __float_as_int(ss[r]), 0x4E, 0xF, 0xF, true));
            ss[r] += __int_as_float(__builtin_amdgcn_update_dpp(0, __float_as_int(ss[r]), 0x141, 0xF, 0xF, true));
            ss[r] += __int_as_float(__builtin_amdgcn_update_dpp(0, __float_as_int(ss[r]), 0x140, 0xF, 0xF, true));
            ss[r] += __shfl_xor(ss[r], 16);
            ss[r] = __builtin_amdgcn_rsqf(ss[r] * (1.f / 128.f) + SUBLN_EPS) * (1.f - LAM_INIT);
        }
#pragma unroll
        for (int d = 0; d < 4; ++d) { const float w = P.subw[d * 32 + r32];
#pragma unroll
            for (int r = 0; r < 16; ++r) o[d][r] = o[d][r] * ss[r] * w; }
    }
    {
#pragma unroll
        for (int d = 0; d < 4; ++d)
#pragma unroll
            for (int r = 0; r < 16; ++r) { const float v = o[d][r]; const float vn = __int_as_float(__builtin_amdgcn_update_dpp(0, __float_as_int(v), 0xB1, 0xF, 0xF, true));
                if ((r32 & 1) == 0) *(LAS unsigned*)(stg + crow(r, hi) * SPITCH + (d * 32 + r32) * 2) = cvt_pk_bf16(v, vn); }
        asm volatile("s_waitcnt lgkmcnt(0)" ::: "memory");
        const size_t grow0 = (size_t)(b * SEQ + qlo); const int gcol0 = (DF ? 1024 : 0) + h * HD;
        u32x4 gv[8];
#pragma unroll
        for (int it = 0; it < 8; ++it) { const int c = it * 64 + lane_e, row = c >> 4, ch = c & 15; gv[it] = __builtin_nontemporal_load((const u32x4*)(P.G + (grow0 + row) * DM + gcol0 + ch * 8)); }
#pragma unroll
        for (int it = 0; it < 8; ++it) { const int c = it * 64 + lane_e, row = c >> 4, ch = c & 15;
            const u32x4 ov = *(LAS const u32x4*)(stg + row * SPITCH + ch * 16);
            const size_t goff = (grow0 + row) * DM + gcol0 + ch * 8;
            u32x4 w;
            w.x = cvt_pk_bf16(bf_lo(ov.x) * bf_lo(gv[it].x), bf_hi(ov.x) * bf_hi(gv[it].x)); w.y = cvt_pk_bf16(bf_lo(ov.y) * bf_lo(gv[it].y), bf_hi(ov.y) * bf_hi(gv[it].y));
            w.z = cvt_pk_bf16(bf_lo(ov.z) * bf_lo(gv[it].z), bf_hi(ov.z) * bf_hi(gv[it].z)); w.w = cvt_pk_bf16(bf_lo(ov.w) * bf_lo(gv[it].w), bf_hi(ov.w) * bf_hi(gv[it].w));
            if (!(VAR & 1)) *(u32x4*)(P.MIX + goff) = w; }
    }
}

#undef KSWZ
#undef SBAR
}

#define XB_TMO      128
#define XB_XCNT(j)  (256  + 64 * (j))
#define XB_XSUB(j)  (1280 + 64 * (j))
#define XB_XGEN(j)  (2304 + 64 * (j))
#define XB_TOP      3328
#define XB_TOPGEN   3392
#define XCD_BAR_WORDS 3456
#define XB_SPIN_CAP (1u << 18)
DI unsigned xb_ld(unsigned* p)              { return __hip_atomic_load(p, __ATOMIC_RELAXED, __HIP_MEMORY_SCOPE_AGENT); }
DI unsigned xb_add(unsigned* p, unsigned v) { return __hip_atomic_fetch_add(p, v, __ATOMIC_RELAXED, __HIP_MEMORY_SCOPE_AGENT); }
DI unsigned xb_xcc_id() { return (unsigned)__builtin_amdgcn_s_getreg((3 << 11) | 20) & 0xFu; }
#define XB_SPIN(cond, bar) do { unsigned _sp = 0; while (cond) { __builtin_amdgcn_s_sleep(1); \
    if ((++_sp & 255u) == 0u) { if (xb_ld(&(bar)[XB_TMO])) break; if (_sp > XB_SPIN_CAP) { atomicAdd(&(bar)[XB_TMO], 1u); break; } } } } while (0)
struct XcdBarrier { unsigned* bar; unsigned x; volatile LAS unsigned* st; };
DI XcdBarrier xcd_barrier_post(unsigned* bar, volatile LAS unsigned* st) {
    XcdBarrier b; b.bar = bar; b.x = xb_xcc_id(); b.st = st;
    if (threadIdx.x == 0) (void)xb_add(&bar[XB_XCNT(b.x)], 1u);
    return b;
}
DI void xcd_barrier_complete(unsigned* bar, unsigned x, unsigned& nloc, unsigned& nx) {
    const unsigned G = gridDim.x * gridDim.y * gridDim.z;
    unsigned sum, cnt, mine, sp = 0u;
    for (;;) {
        sum = 0u; cnt = 0u; mine = 0u;
#pragma unroll
        for (unsigned j = 0; j < 16; ++j) { const unsigned c = xb_ld(&bar[XB_XCNT(j)]); sum += c; cnt += (c > 0u) ? 1u : 0u; mine = (j == x) ? c : mine; }
        if (sum == G) break;
        __builtin_amdgcn_s_sleep(1);
        if ((++sp & 255u) == 0u) { if (xb_ld(&bar[XB_TMO])) break; if (sp > XB_SPIN_CAP) { atomicAdd(&bar[XB_TMO], 1u); break; } }
    }
    nloc = mine > 0u ? mine : 1u; nx = cnt > 0u ? cnt : 1u;
}
DI void xcd_barrier(const XcdBarrier& b) {
    asm volatile("s_waitcnt vmcnt(0)" ::: "memory");
    __syncthreads();
    if (threadIdx.x == 0) {
        unsigned* bar = b.bar;
        __builtin_amdgcn_s_waitcnt(0);
        unsigned nloc = b.st[0], nx = b.st[1];
        if (nloc == 0u) { xcd_barrier_complete(bar, b.x, nloc, nx); b.st[0] = nloc; b.st[1] = nx; }
        const unsigned old = xb_add(&bar[XB_XSUB(b.x)], 1u);
        const unsigned gen = old / nloc;
        if (old + 1u == (gen + 1u) * nloc) {
            __builtin_amdgcn_fence(__ATOMIC_RELEASE, "agent");
            asm volatile("s_waitcnt vmcnt(0)" ::: "memory");
            const unsigned og = xb_add(&bar[XB_TOP], 1u);
            const unsigned tg = og / nx;
            if (og + 1u == (tg + 1u) * nx) xb_add(&bar[XB_TOPGEN], 1u);
            else XB_SPIN(xb_ld(&bar[XB_TOPGEN]) == tg, bar);
            __builtin_amdgcn_fence(__ATOMIC_ACQUIRE, "agent");
            xb_add(&bar[XB_XGEN(b.x)], 1u);
            asm volatile("s_waitcnt vmcnt(0)" ::: "memory");
        } else {
            XB_SPIN(xb_ld(&bar[XB_XGEN(b.x)]) == gen, bar);
            __builtin_amdgcn_fence(__ATOMIC_ACQUIRE, "agent");
            asm volatile("s_waitcnt vmcnt(0)" ::: "memory");
        }
    }
    __syncthreads();
}

DI void p0_transpose_item(const float* W, int K, int N, bf16_t* WT, LAS float* scr, int item, int lane) {
    const int nblk = N / 32, kb = item / nblk, nb = item % nblk, k0 = 64 * kb, n0 = 32 * nb;
#pragma unroll 8
    for (int i = 0; i < 32; ++i) { const int kk = 2 * i + (lane >> 5); scr[kk * 33 + (lane & 31)] = __builtin_nontemporal_load(W + (size_t)(k0 + kk) * N + n0 + (lane & 31)); }
    asm volatile("s_waitcnt lgkmcnt(0)" ::: "memory");
    const int c = lane & 7;
#pragma unroll
    for (int j = 0; j < 4; ++j) { const int n = (lane >> 3) + 8 * j; const LAS float* s = scr + (8 * c) * 33 + n;
        u32x4 o; o.x = cvt_pk_bf16(s[0 * 33], s[1 * 33]); o.y = cvt_pk_bf16(s[2 * 33], s[3 * 33]); o.z = cvt_pk_bf16(s[4 * 33], s[5 * 33]); o.w = cvt_pk_bf16(s[6 * 33], s[7 * 33]);
        *(u32x4*)(WT + (size_t)(n0 + n) * K + k0 + 8 * c) = o; }
    asm volatile("s_waitcnt lgkmcnt(0)" ::: "memory");
}
DI void sincos_d(double a, double& s, double& c) {
    const double k = __builtin_rint(a * 0.63661977236758134308);
    const double y = (a - k * 1.57079632679489655800) - k * 6.123233995736766e-17;
    const double y2 = y * y;
    double sp = -1.0 / 1307674368000.0; sp = sp * y2 + 1.0 / 6227020800.0; sp = sp * y2 - 1.0 / 39916800.0; sp = sp * y2 + 1.0 / 362880.0; sp = sp * y2 - 1.0 / 5040.0; sp = sp * y2 + 1.0 / 120.0; sp = sp * y2 - 1.0 / 6.0; sp = sp * y2 + 1.0;
    const double sy = sp * y;
    double cp = 1.0 / 20922789888000.0; cp = cp * y2 - 1.0 / 87178291200.0; cp = cp * y2 + 1.0 / 479001600.0; cp = cp * y2 - 1.0 / 3628800.0; cp = cp * y2 + 1.0 / 40320.0; cp = cp * y2 - 1.0 / 720.0; cp = cp * y2 + 1.0 / 24.0; cp = cp * y2 - 0.5; cp = cp * y2 + 1.0;
    const int q = ((int)k) & 3;
    s = (q == 0) ? sy : (q == 1) ? cp : (q == 2) ? -sy : -cp;
    c = (q == 0) ? cp : (q == 1) ? -sy : (q == 2) ? -cp : sy;
}
DI int meta_col(int c64) { const int grp = c64 >> 4, c = c64 & 15; const int base = (grp == 0) ? 1024 : (grp == 1) ? 2048 : (grp == 2) ? 5120 : 6144; return base + c * 64; }

struct Args { const float* in[12]; float* out; unsigned char* ws; int ph_lo, ph_hi, coop, pad; };

__global__ void __launch_bounds__(512, 2) hybrid_fwd(Args args) {
    extern __shared__ __attribute__((aligned(16))) unsigned char lds_raw[];
    LAS unsigned char* lds = (LAS unsigned char*)lds_raw;
    const int tid = threadIdx.x, lane = tid & 63, wave = __builtin_amdgcn_readfirstlane(tid >> 6);
    const int G = gridDim.x, bx = blockIdx.x;
    const int gw = bx * 8 + wave, NGW = G * 8;
    unsigned char* ws = args.ws;
    const float* x = args.in[0]; const float* meta = args.in[1]; const float* norm_w = args.in[2]; const float* w_in = args.in[3];
    const float* qnw = args.in[4]; const float* knw = args.in[5]; const float* lq1 = args.in[6]; const float* lk1 = args.in[7];
    const float* lq2 = args.in[8]; const float* lk2 = args.in[9]; const float* subw = args.in[10]; const float* w_out = args.in[11];
    float* ctlf = (float*)(ws + WS_CTL); unsigned* ctlu = (unsigned*)(ws + WS_CTL);
    float* rope = (float*)(ws + WS_ROPE); float* mpart = (float*)(ws + WS_MPART);
    bf16_t* WinT = (bf16_t*)(ws + WS_WIN); bf16_t* WoutT = (bf16_t*)(ws + WS_WOUT); bf16_t* XN = (bf16_t*)(ws + WS_XN);
    bf16_t* Gt = (bf16_t*)(ws + WS_G); bf16_t* MIX = (bf16_t*)(ws + WS_MIX);
    bf16_t* sbQ = (bf16_t*)(ws + WS_SBQ); bf16_t* sbK = (bf16_t*)(ws + WS_SBK); bf16_t* sbV = (bf16_t*)(ws + WS_SBV);
    bf16_t* dfQ = (bf16_t*)(ws + WS_DFQ); bf16_t* dfK = (bf16_t*)(ws + WS_DFK); bf16_t* dfV = (bf16_t*)(ws + WS_DFV);
    const int lo = args.ph_lo, hi_ph = args.ph_hi;
#define IN(k) (lo <= (k) && (k) < hi_ph)
    { volatile LAS unsigned* st0 = (volatile LAS unsigned*)(lds + 138240); if (tid < 2) st0[tid] = 0u; }
    __syncthreads();
    const XcdBarrier xbar = xcd_barrier_post((unsigned*)(ws + WS_CTL) + 4096, (volatile LAS unsigned*)(lds + 138240));
#define SEAM(k) do { if (IN(k) && IN((k) + 1)) { if (args.coop == 2) cg::this_grid().sync(); else xcd_barrier(xbar); } } while (0)

    if (IN(0)) {
      for (int rep0 = 0; rep0 < REPS(0); ++rep0) {
        LAS float* scr = (LAS float*)(lds + wave * 16384);
        constexpr int I_IN = (DM / 64) * (INW / 32), I_OUT = (DM / 64) * (DM / 32);
        const int gw4 = bx * 4 + (wave & 3), NGW4 = G * 4;
        if (wave < 4) {
        for (int it = gw4; it < I_IN + I_OUT; it += NGW4) {
            if (it < I_IN) p0_transpose_item(w_in, DM, INW, WinT, scr, it, lane);
            else p0_transpose_item(w_out, DM, DM, WoutT, scr, it - I_IN, lane);
        }
        }
        {
            f32x4 nw[8];
#pragma unroll
            for (int j = 0; j < 8; ++j) nw[j] = ((const f32x4*)norm_w)[64 * j + lane];
            if (wave >= 4)
            for (int m = gw4; m < MROWS; m += 2 * NGW4) {
                const int m2 = m + NGW4;
                const bool has2 = m2 < MROWS;
                const f32x4* xr = (const f32x4*)(x + (size_t)m * DM) + lane;
                const f32x4* xr2 = (const f32x4*)(x + (size_t)(has2 ? m2 : m) * DM) + lane;
                f32x4 v[8], u[8]; float s = 0.f, s2 = 0.f;
#pragma unroll
                for (int j = 0; j < 8; ++j) { v[j] = __builtin_nontemporal_load(xr + 64 * j); u[j] = __builtin_nontemporal_load(xr2 + 64 * j); }
#pragma unroll
                for (int j = 0; j < 8; ++j) { s += (v[j].x * v[j].x + v[j].y * v[j].y) + (v[j].z * v[j].z + v[j].w * v[j].w); s2 += (u[j].x * u[j].x + u[j].y * u[j].y) + (u[j].z * u[j].z + u[j].w * u[j].w); }
                const float rstd = __builtin_amdgcn_rsqf(wave_sum(s) * (1.f / DM) + RMS_EPS), rstd2 = __builtin_amdgcn_rsqf(wave_sum(s2) * (1.f / DM) + RMS_EPS);
                u32x2* o8 = (u32x2*)(XN + (size_t)m * DM) + lane;
#pragma unroll
                for (int j = 0; j < 8; ++j) { const f32x4 y = v[j] * rstd * nw[j]; u32x2 w; w.x = cvt_pk_bf16(y.x, y.y); w.y = cvt_pk_bf16(y.z, y.w); o8[64 * j] = w; }
                if (has2) { u32x2* o82 = (u32x2*)(XN + (size_t)m2 * DM) + lane;
#pragma unroll
                    for (int j = 0; j < 8; ++j) { const f32x4 y = u[j] * rstd2 * nw[j]; u32x2 w; w.x = cvt_pk_bf16(y.x, y.y); w.y = cvt_pk_bf16(y.z, y.w); o82[64 * j] = w; } }
            }
        }
        for (int it = gw; it < 64 * 32; it += NGW) {
            const int c64 = it & 63, kc = it >> 6, col = meta_col(c64) + lane, k0 = kc * 64;
            float ml[16];
            const float nwl = norm_w[k0 + lane];
#pragma unroll
            for (int r = 0; r < 16; ++r) ml[r] = meta[(size_t)r * DM + k0 + lane] * nwl;
            float acc[16];
#pragma unroll
            for (int r = 0; r < 16; ++r) acc[r] = 0.f;
            for (int kk = 0; kk < 64; ++kk) {
                const float w = w_in[(size_t)(k0 + kk) * INW + col];
#pragma unroll
                for (int r = 0; r < 16; ++r) acc[r] += __int_as_float(__builtin_amdgcn_readlane(__float_as_int(ml[r]), kk)) * w;
            }
#pragma unroll
            for (int r = 0; r < 16; ++r) mpart[(size_t)(kc * 16 + r) * 4096 + c64 * 64 + lane] = acc[r];
        }
        for (int idx = bx * 512 + tid; idx < (NMETA + SEQ) * 8; idx += G * 512) {
            const int pos = idx >> 3, f = idx & 7;
            const float invf = (f == 0) ? 1.0f : (f == 1) ? 0.1939227432012558f : (f == 2) ? 0.03760603070259094f : (f == 3) ? 0.007292664609849453f :
                               (f == 4) ? 0.0014142135623842478f : (f == 5) ? 0.00027424818836152554f : (f == 6) ? 5.318296098266728e-05f : 1.0313386155758053e-05f;
            const float ang = (float)pos * invf;
            double s, c; sincos_d((double)ang, s, c);
            rope[pos * 16 + f] = (float)c; rope[pos * 16 + 8 + f] = (float)s;
        }
        for (int idx = bx * 512 + tid; idx < 4 * NBH * 48 * 16; idx += G * 512) {
            const int arr = idx / (NBH * 48 * 16), r = idx % (NBH * 48 * 16), bhh = r / (48 * 16), ch = r % (48 * 16);
            size_t aoff = WS_SBK; if (arr == 1) aoff = WS_SBV; if (arr == 2) aoff = WS_DFK; if (arr == 3) aoff = WS_DFV;
            bf16_t* base = (bf16_t*)(ws + aoff);
            *(u32x4*)(base + (size_t)bhh * TPAD * HD + ch * 8) = (u32x4){0u, 0u, 0u, 0u};
        }
        if (bx == 0 && wave == 0) {
            const float s1 = wave_sum(lq1[lane] * lk1[lane]), s2 = wave_sum(lq2[lane] * lk2[lane]);
            const float mq = wave_max(fabsf(qnw[lane])), mk = wave_max(fabsf(knw[lane]));
            if (lane == 0) { ctlf[CW_LAM] = __expf(s1) - __expf(s2) + LAM_INIT; ctlf[CW_BOFF] = 8.f * mq * mk * LOG2E * 1.02f; }
            if (lane < 8) ctlu[CW_QUEUE + 64 * lane] = 0u;
        }
        if (rep0 + 1 < REPS(0)) __syncthreads();
      }
    }
    SEAM(0);
    if (PROBE_PHASE == 7) { for (int i = 0; i < 10; ++i) cg::this_grid().sync(); }

    if (IN(1)) {
        for (int it = gw; it < 64 * 16; it += NGW) {
            const int c64 = it & 63, r = it >> 6;
            float v = 0.f;
            for (int kc = 0; kc < 32; ++kc) v += mpart[(size_t)(kc * 16 + r) * 4096 + c64 * 64 + lane];
            float s = 0.f;
            for (int j = 0; j < 32; ++j) { const float mv = meta[(size_t)r * DM + j * 64 + lane]; s += mv * mv; }
            v *= __builtin_amdgcn_rsqf(wave_sum(s) * (1.f / DM) + RMS_EPS);
            const int grp = c64 >> 4, c = c64 & 15;
            if (grp == 2) {
                const float ss = wave_sum(v * v);
                v = v * __builtin_amdgcn_rsqf(ss * (1.f / 64.f) + RMS_EPS) * knw[lane];
                const float pr = __shfl_xor(v, 8);
                if (lane < 16) { const float cs = rope[r * 16 + (lane & 7)], sn = rope[r * 16 + 8 + (lane & 7)]; v = (lane < 8) ? v * cs - pr * sn : v * cs + pr * sn; }
            }
            size_t aoff = WS_SBK; if (grp == 1) aoff = WS_SBV; if (grp == 2) aoff = WS_DFK; if (grp == 3) aoff = WS_DFV;
            bf16_t* arr = (bf16_t*)(ws + aoff);
            const bf16_t hv = (bf16_t)(cvt_pk_bf16(v, v) & 0xffffu);
            for (int bb = 0; bb < BATCH; ++bb) arr[((size_t)(bb * NH + (c >> 1)) * TPAD + 48 + r) * HD + (c & 1) * 64 + lane] = hv;
        }
        pg8::Gemm g{XN, WinT, MROWS, INW, DM}; pg8::StaticOrder S; S.init(MROWS, INW, G, bx);
        EpiIn E{ws, qnw, knw, rope};
        pg8::gemm_phase<EpiIn, pg8::StaticOrder>(lds, g, S, E);
        if constexpr (PROBE_PHASE == 1) { cg::this_grid().sync(); pg8::gemm_phase<EpiIn, pg8::StaticOrder>(lds, g, S, E); }
    }
    SEAM(1);

    if (IN(2)) {
        att::Ptrs P{sbQ, sbK, sbV, dfQ, dfK, dfV, Gt, MIX, subw, ctlf[CW_LAM], ctlf[CW_BOFF]};
        LAS unsigned* ctrl = (LAS unsigned*)(lds + att::L_CTRL);
        const unsigned xcc = (unsigned)__builtin_amdgcn_s_getreg((3 << 11) | 20) & 7u;
        for (int rep = 0; rep < REPS(2); ++rep) {
        unsigned q = xcc, nxt = 0xffffffffu; int slot = 0;
#define QPOP(qstart) do { unsigned qq = (qstart), L_ = 256u; \
            for (int t = 0; t < 8; ++t) { L_ = atomicAdd(ctlu + CW_QUEUE + 64 * qq, 1u); if (L_ < 256u) break; qq = (qq + 1) & 7u; } \
            nxt = (L_ < 256u) ? ((qq << 8) | L_) : 0xffffffffu; } while (0)
        if (tid == 0) QPOP(q);
        for (;;) {
            if (tid == 0) ctrl[slot] = nxt;
            __syncthreads();
            const unsigned v = (unsigned)__builtin_amdgcn_readfirstlane((int)ctrl[slot]);
            slot ^= 1;
            if (v == 0xffffffffu) break;
            q = v >> 8; const int L = (int)(v & 255u), w = L & 127, pr = w >> 5, wi = w & 31, qb = 15 - (wi >> 1), bh = (int)q * 8 + 2 * pr + (wi & 1);
            if (tid == 0) QPOP(q);
            if (L < 128) att::attn_unit<1>(P, bh, qb, lds);
            else att::attn_unit<0>(P, bh, qb, lds);
        }
#undef QPOP
        if (rep + 1 < REPS(2)) { cg::this_grid().sync(); if (bx == 0 && tid < 8) ctlu[CW_QUEUE + 64 * tid] = 0u; __threadfence(); cg::this_grid().sync(); }
        }
    }
    SEAM(2);

    if (IN(3)) {
        pg8::Gemm g{MIX, WoutT, MROWS, DM, DM}; pg8::StaticOrder S; S.init(MROWS, DM, G, bx);
        EpiOut E{x, args.out};
        pg8::gemm_phase<EpiOut, pg8::StaticOrder>(lds, g, S, E);
        if constexpr (PROBE_PHASE == 3) { cg::this_grid().sync(); pg8::gemm_phase<EpiOut, pg8::StaticOrder>(lds, g, S, E); }
    }
#undef IN
#undef SEAM
}

extern "C" void kernel_launch(void* const* d_in, const int* in_sizes, int n_in, void* d_out, int out_size, void* d_ws, size_t ws_size, hipStream_t stream) {
    static int grid = 0;
    if (grid == 0) {
        if (n_in != 12 || in_sizes[0] != MROWS * DM || out_size != MROWS * DM || ws_size < WS_END) { fprintf(stderr, "kernel_launch: unexpected shapes (n_in %d, ws %zu)\n", n_in, ws_size); grid = -1; return; }
        int dev = 0, cus = 0, per_cu = 0;
        (void)hipGetDevice(&dev); (void)hipDeviceGetAttribute(&cus, hipDeviceAttributeMultiprocessorCount, dev);
        if (hipFuncSetAttribute((const void*)hybrid_fwd, hipFuncAttributeMaxDynamicSharedMemorySize, LDS_BYTES) != hipSuccess) { fprintf(stderr, "kernel_launch: hipFuncSetAttribute failed\n"); grid = -1; return; }
        if (hipOccupancyMaxActiveBlocksPerMultiprocessor(&per_cu, (const void*)hybrid_fwd, 512, LDS_BYTES) != hipSuccess || per_cu < 1) per_cu = 1;
        (void)hipGetLastError();
        grid = cus > 0 ? cus * per_cu : 256;
    }
    if (grid < 0) return;
    if (hipMemsetAsync((char*)d_ws + WS_CTL, 0, 65536, stream) != hipSuccess) { fprintf(stderr, "kernel_launch: hipMemsetAsync failed\n"); return; }
    Args a{};
    for (int i = 0; i < 12; ++i) a.in[i] = (const float*)d_in[i];
    a.out = (float*)d_out; a.ws = (unsigned char*)d_ws; a.ph_lo = 0; a.ph_hi = 4; a.coop = 1; a.pad = 0;
    void* kargs[] = {&a};
    hipError_t e = hipLaunchCooperativeKernel((const void*)hybrid_fwd, dim3(grid), dim3(512), kargs, LDS_BYTES, stream);
    if (e != hipSuccess) fprintf(stderr, "kernel_launch: cooperative launch failed: %s (grid %d)\n", hipGetErrorString(e), grid);
}
```
